# Optimizing an MI355X kernel written in HIP

```python
import jax, jax.numpy as jnp
from jax import lax
import numpy as np


D_MODEL = 1024
BATCH = 8
SEQ = 2048
DEPTH = 2

HEAD_DIM = 64
ROPE_THETA = 10000.0
LN_EPS = 1e-5
A_HEADS = 8
IDX_HEADS = 8
IDX_DIM = 32
DSA_TOPK = 256
DSA_QBLOCK = 128
B_HEADS = 8
B_GROUPS = ((128, 1), (512, 4), (2048, 16))
B_QBLOCK = 128
C_HEADS = 8
MOBA_BLOCK = 256
MOBA_TOPK = 3
MOBA_QCHUNK = 32
N_EXPERTS = 64
N_GROUPS = 8
TOPK_GROUPS = 4
TOP_K = 8
EXPERT_DIM = 256
SHARED_DIM = 256
ROUTED_SCALE = 2.5
ALPHA = (2 * DEPTH) ** 0.25
BETA = (8 * DEPTH) ** -0.25
IN_WIDTHS = (A_HEADS * HEAD_DIM, HEAD_DIM, HEAD_DIM, IDX_HEADS * IDX_DIM, IDX_DIM, IDX_HEADS,
             B_HEADS * HEAD_DIM, B_HEADS * HEAD_DIM, B_HEADS * HEAD_DIM,
             C_HEADS * HEAD_DIM, C_HEADS * HEAD_DIM, C_HEADS * HEAD_DIM,
             D_MODEL, D_MODEL, D_MODEL)
IN_WIDTH = sum(IN_WIDTHS)

kernel_name = 'hybrid_dsa_dilated_moba_moe_block'

F32 = jnp.float32


def layer_norm(x, g, b):
    xf = x.astype(F32)
    mu = xf.mean(-1, keepdims=True)
    var = jnp.mean(jnp.square(xf - mu), -1, keepdims=True)
    return ((xf - mu) * lax.rsqrt(var + LN_EPS) * g.astype(F32) + b.astype(F32)).astype(x.dtype)


def rope_tables(seq, dim):
    inv = ROPE_THETA ** (-jnp.arange(0, dim, 2, dtype=F32) / dim)
    ang = jnp.arange(seq, dtype=F32)[:, None] * inv[None, :]
    return jnp.cos(ang), jnp.sin(ang)


def apply_rope(x, cos, sin):
    extra = x.ndim - 3
    cos = cos.reshape(cos.shape[:1] + (1,) * extra + cos.shape[1:])
    sin = sin.reshape(sin.shape[:1] + (1,) * extra + sin.shape[1:])
    x1, x2 = jnp.split(x.astype(F32), 2, axis=-1)
    return jnp.concatenate([x1 * cos - x2 * sin, x2 * cos + x1 * sin], -1).astype(x.dtype)


def dsa_attention(q, k, v, qi, ki, wi):
    bsz, S, _, dh = q.shape
    topk = min(DSA_TOPK, S // 4)
    kpos = jnp.arange(S)
    def block(i):
        t0 = i * DSA_QBLOCK
        tq = t0 + jnp.arange(DSA_QBLOCK)
        qb = lax.dynamic_slice_in_dim(q, t0, DSA_QBLOCK, axis=1)
        qib = lax.dynamic_slice_in_dim(qi, t0, DSA_QBLOCK, axis=1)
        wib = lax.dynamic_slice_in_dim(wi, t0, DSA_QBLOCK, axis=1).astype(F32) * IDX_HEADS ** -0.5
        dots = jnp.einsum('bqhe,bse->bhqs', qib, ki, preferred_element_type=F32) * IDX_DIM ** -0.5
        score = jnp.einsum('bqh,bhqs->bqs', wib, jax.nn.relu(dots))
        causal = kpos[None, :] <= tq[:, None]
        score = jnp.where(causal[None], score, -jnp.inf)
        _, idx = lax.top_k(score, topk)
        valid = idx <= tq[None, :, None]
        kg = jax.vmap(lambda kk, ii: kk[ii])(k, idx)
        vg = jax.vmap(lambda vv, ii: vv[ii])(v, idx)
        logits = jnp.einsum('bqhd,bqkd->bhqk', qb, kg, preferred_element_type=F32) * dh ** -0.5
        logits = jnp.where(valid[:, None], logits, -jnp.inf)
        p = jax.nn.softmax(logits, axis=-1).astype(v.dtype)
        return jnp.einsum('bhqk,bqkd->bqhd', p, vg)
    out = lax.map(block, jnp.arange(S // DSA_QBLOCK))
    return jnp.moveaxis(out, 0, 1).reshape(bsz, S, -1)


def dilated_attention(q, k, v):
    bsz, S, H, dh = q.shape
    scale = dh ** -0.5
    def block(i):
        t0 = i * B_QBLOCK
        tq = t0 + jnp.arange(B_QBLOCK)
        qb = lax.dynamic_slice_in_dim(q, t0, B_QBLOCK, axis=1)
        ms, ls, outs = [], [], []
        for window, dil in B_GROUPS:
            n_keys = window // dil + 1
            kpos = tq[:, None] - dil * jnp.arange(n_keys)[None, :]
            valid = kpos >= 0
            kpos = jnp.maximum(kpos, 0)
            kg = k[:, kpos]
            vg = v[:, kpos]
            logits = jnp.einsum('bqhd,bqnhd->bhqn', qb, kg, preferred_element_type=F32) * scale
            logits = jnp.where(valid[None, None], logits, -jnp.inf)
            m = logits.max(-1)
            e = jnp.exp(logits - m[..., None])
            l = e.sum(-1)
            o = jnp.einsum('bhqn,bqnhd->bhqd', (e / l[..., None]).astype(v.dtype), vg,
                           preferred_element_type=F32)
            ms.append(m); ls.append(l); outs.append(o)
        m_all, l_all, o_all = jnp.stack(ms), jnp.stack(ls), jnp.stack(outs)
        wgt = l_all * jnp.exp(m_all - m_all.max(0))
        o = (wgt[..., None] * o_all).sum(0) / wgt.sum(0)[..., None]
        return o.transpose(0, 2, 1, 3).astype(q.dtype)
    out = lax.map(block, jnp.arange(S // B_QBLOCK))
    return jnp.moveaxis(out, 0, 1).reshape(bsz, S, -1)


def moba_attention(q, k, v):
    bsz, S, H, dh = q.shape
    scale = dh ** -0.5
    n_blk = -(-S // MOBA_BLOCK)
    pad = n_blk * MOBA_BLOCK - S
    k_pad = jnp.pad(k, ((0, 0), (0, pad), (0, 0), (0, 0)))
    v_pad = jnp.pad(v, ((0, 0), (0, pad), (0, 0), (0, 0)))
    k_blk = k_pad.reshape(bsz, n_blk, MOBA_BLOCK, H, dh).transpose(0, 3, 1, 2, 4)
    v_blk = v_pad.reshape(bsz, n_blk, MOBA_BLOCK, H, dh).transpose(0, 3, 1, 2, 4)
    k_mean = k_blk.astype(F32).mean(3)
    n_sel = max(1, min(MOBA_TOPK, n_blk - 1))
    b_ix = jnp.arange(bsz)[:, None, None, None]
    h_ix = jnp.arange(H)[None, :, None, None]
    blk_ids = jnp.arange(n_blk)
    def chunk(i):
        t0 = i * MOBA_QCHUNK
        tq = t0 + jnp.arange(MOBA_QCHUNK)
        own = t0 // MOBA_BLOCK
        qc = lax.dynamic_slice_in_dim(q, t0, MOBA_QCHUNK, axis=1)
        gate = jnp.einsum('bqhd,bhnd->bhqn', qc.astype(F32), k_mean)
        gate = jnp.where(blk_ids < own, gate, -jnp.inf)
        _, sel = lax.top_k(gate, n_sel)
        sel_ok = sel < own
        kg = k_blk[b_ix, h_ix, sel]
        vg = v_blk[b_ix, h_ix, sel]
        lp = jnp.einsum('bqhd,bhqkjd->bhqkj', qc, kg, preferred_element_type=F32) * scale
        lp = jnp.where(sel_ok[..., None], lp, -jnp.inf).reshape(bsz, H, MOBA_QCHUNK, n_sel * MOBA_BLOCK)
        start = own * MOBA_BLOCK
        k_own = lax.dynamic_slice_in_dim(k_pad, start, MOBA_BLOCK, axis=1)
        v_own = lax.dynamic_slice_in_dim(v_pad, start, MOBA_BLOCK, axis=1)
        lo = jnp.einsum('bqhd,bjhd->bhqj', qc, k_own, preferred_element_type=F32) * scale
        causal = (start + jnp.arange(MOBA_BLOCK))[None, :] <= tq[:, None]
        lo = jnp.where(causal, lo, -jnp.inf)
        p = jax.nn.softmax(jnp.concatenate([lp, lo], -1), axis=-1).astype(v.dtype)
        p_sel = p[..., :n_sel * MOBA_BLOCK].reshape(bsz, H, MOBA_QCHUNK, n_sel, MOBA_BLOCK)
        p_own = p[..., n_sel * MOBA_BLOCK:]
        return (jnp.einsum('bhqkj,bhqkjd->bqhd', p_sel, vg)
                + jnp.einsum('bhqj,bjhd->bqhd', p_own, v_own))
    out = lax.map(chunk, jnp.arange(S // MOBA_QCHUNK))
    return jnp.moveaxis(out, 0, 1).reshape(bsz, S, -1)


def token_mixing(u, w_in, ik_g, ik_b, w_br_a, w_br_b, w_br_c, w_out):
    bsz, S, _ = u.shape
    cos_h, sin_h = rope_tables(S, HEAD_DIM)
    cos_i, sin_i = rope_tables(S, IDX_DIM)
    proj = jnp.einsum('bsd,dn->bsn', u, w_in)
    parts = jnp.split(proj, np.cumsum(IN_WIDTHS)[:-1].tolist(), axis=-1)
    qa, ka, va, qi, ki, wi, qb, kb, vb, qc, kc, vc, ga, gb, gc = parts
    heads = lambda t, h: t.reshape(bsz, S, h, -1)
    qa = apply_rope(heads(qa, A_HEADS), cos_h, sin_h)
    ka = apply_rope(ka, cos_h, sin_h)
    qi = apply_rope(heads(qi, IDX_HEADS), cos_i, sin_i)
    ki = apply_rope(layer_norm(ki, ik_g, ik_b), cos_i, sin_i)
    o_a = dsa_attention(qa, ka, va, qi, ki, wi)
    o_b = dilated_attention(apply_rope(heads(qb, B_HEADS), cos_h, sin_h),
                            apply_rope(heads(kb, B_HEADS), cos_h, sin_h), heads(vb, B_HEADS))
    o_c = moba_attention(apply_rope(heads(qc, C_HEADS), cos_h, sin_h),
                         apply_rope(heads(kc, C_HEADS), cos_h, sin_h), heads(vc, C_HEADS))
    merged = (jax.nn.sigmoid(ga) * jnp.einsum('bsk,kd->bsd', o_a, w_br_a)
              + jax.nn.sigmoid(gb) * jnp.einsum('bsk,kd->bsd', o_b, w_br_b)
              + jax.nn.sigmoid(gc) * jnp.einsum('bsk,kd->bsd', o_c, w_br_c))
    return jnp.einsum('bsd,de->bse', merged, w_out)


def moe_ffn(u, w_router, router_bias, w_gate, w_up, w_down, ws_gate, ws_up, ws_down):
    bsz, S, _ = u.shape
    scores = jax.nn.sigmoid(jnp.einsum('bsd,de->bse', u, w_router, preferred_element_type=F32))
    biased = scores + router_bias.astype(F32)
    grp = biased.reshape(bsz, S, N_GROUPS, N_EXPERTS // N_GROUPS)
    grp_score = lax.top_k(grp, 2)[0].sum(-1)
    _, gidx = lax.top_k(grp_score, TOPK_GROUPS)
    gmask = jax.nn.one_hot(gidx, N_GROUPS, dtype=F32).sum(-2) > 0
    emask = jnp.repeat(gmask, N_EXPERTS // N_GROUPS, axis=-1)
    _, eidx = lax.top_k(jnp.where(emask, biased, -jnp.inf), TOP_K)
    w = jnp.take_along_axis(scores, eidx, -1)
    w = w / w.sum(-1, keepdims=True) * ROUTED_SCALE
    gates = (jax.nn.one_hot(eidx, N_EXPERTS, dtype=F32) * w[..., None]).sum(-2)
    def per_seq(args):
        us, gs = args
        h = (jax.nn.silu(jnp.einsum('sd,edf->sef', us, w_gate))
             * jnp.einsum('sd,edf->sef', us, w_up)) * gs[..., None].astype(us.dtype)
        return jnp.einsum('sef,efd->sd', h, w_down)
    routed = lax.map(per_seq, (u, gates))
    shared = jnp.einsum('bsf,fd->bsd', jax.nn.silu(jnp.einsum('bsd,df->bsf', u, ws_gate))
                        * jnp.einsum('bsd,df->bsf', u, ws_up), ws_down)
    return routed + shared


def setup_inputs(seed: int = 0) -> dict:
    key = jax.random.key(seed)
    ks = jax.random.split(key, 24)
    D, L = D_MODEL, DEPTH
    nrm = lambda k, shape, s: jax.random.normal(k, shape, F32) * s
    return {
        'x': nrm(ks[0], (BATCH, SEQ, D), 1.0),
        'c': nrm(ks[1], (BATCH, D), 1.0),
        'ada_w': nrm(ks[2], (L, D, 6 * D), 0.1 * D ** -0.5),
        'ada_b': nrm(ks[3], (L, 6 * D), 0.01),
        'w_in': nrm(ks[4], (L, D, IN_WIDTH), D ** -0.5),
        'ik_norm_g': 1.0 + nrm(ks[5], (L, IDX_DIM), 0.02),
        'ik_norm_b': nrm(ks[6], (L, IDX_DIM), 0.02),
        'w_br_a': nrm(ks[7], (L, A_HEADS * HEAD_DIM, D), (A_HEADS * HEAD_DIM) ** -0.5),
        'w_br_b': nrm(ks[8], (L, B_HEADS * HEAD_DIM, D), (B_HEADS * HEAD_DIM) ** -0.5),
        'w_br_c': nrm(ks[9], (L, C_HEADS * HEAD_DIM, D), (C_HEADS * HEAD_DIM) ** -0.5),
        'w_out': nrm(ks[10], (L, D, D), BETA * D ** -0.5),
        'ln1_g': 1.0 + nrm(ks[11], (L, D), 0.02),
        'ln1_b': nrm(ks[12], (L, D), 0.02),
        'w_router': nrm(ks[13], (L, D, N_EXPERTS), D ** -0.5),
        'router_bias': nrm(ks[14], (L, N_EXPERTS), 0.01),
        'w_gate': nrm(ks[15], (L, N_EXPERTS, D, EXPERT_DIM), D ** -0.5),
        'w_up': nrm(ks[16], (L, N_EXPERTS, D, EXPERT_DIM), D ** -0.5),
        'w_down': nrm(ks[17], (L, N_EXPERTS, EXPERT_DIM, D), BETA * EXPERT_DIM ** -0.5),
        'ws_gate': nrm(ks[18], (L, D, SHARED_DIM), D ** -0.5),
        'ws_up': nrm(ks[19], (L, D, SHARED_DIM), D ** -0.5),
        'ws_down': nrm(ks[20], (L, SHARED_DIM, D), BETA * SHARED_DIM ** -0.5),
        'ln2_g': 1.0 + nrm(ks[21], (L, D), 0.02),
        'ln2_b': nrm(ks[22], (L, D), 0.02),
    }


def reference(x, c, ada_w, ada_b, w_in, ik_norm_g, ik_norm_b, w_br_a, w_br_b, w_br_c, w_out,
              ln1_g, ln1_b, w_router, router_bias, w_gate, w_up, w_down, ws_gate, ws_up, ws_down,
              ln2_g, ln2_b):
    for l in range(DEPTH):
        mod = jnp.einsum('bd,dn->bn', jax.nn.silu(c), ada_w[l]) + ada_b[l]
        sh1, sc1, g1, sh2, sc2, g2 = jnp.split(mod[:, None, :], 6, axis=-1)
        u = x * (1 + sc1) + sh1
        y = token_mixing(u, w_in[l], ik_norm_g[l], ik_norm_b[l], w_br_a[l], w_br_b[l], w_br_c[l], w_out[l])
        x = layer_norm(ALPHA * x + (1 + g1) * y, ln1_g[l], ln1_b[l])
        u = x * (1 + sc2) + sh2
        y = moe_ffn(u, w_router[l], router_bias[l], w_gate[l], w_up[l], w_down[l],
                    ws_gate[l], ws_up[l], ws_down[l])
        x = layer_norm(ALPHA * x + (1 + g2) * y, ln2_g[l], ln2_b[l])
    return x
```

```cpp
#include <hip/hip_runtime.h>
#include <stdint.h>
#include <stdio.h>

#ifndef MK_PER_PHASE
#ifndef XCD_LOCAL
#define XCD_LOCAL 1
#endif
#define MK_PER_PHASE 0
#endif
#ifndef PH_MASK
#define PH_MASK 0xFFFF
#endif
#define HAS(k) (((PH_MASK) >> (k)) & 1)
#ifndef PROBE_PHASE
#define PROBE_PHASE (-1)
#endif
#ifndef PROBE_N
#define PROBE_N 0
#endif
#define NREP(k) (((k) == PROBE_PHASE) ? (1 + PROBE_N) : 1)
#ifndef PROBE_DSA
#define PROBE_DSA 0
#endif
#ifndef EN_MIX
#define EN_MIX 1
#endif

#define LAS __attribute__((address_space(3)))
#define GAS __attribute__((address_space(1)))
typedef unsigned short bf16_t;
typedef short bf16x8 __attribute__((ext_vector_type(8)));
typedef short s16x4 __attribute__((ext_vector_type(4)));
typedef float f32x2 __attribute__((ext_vector_type(2)));
typedef float f32x4 __attribute__((ext_vector_type(4)));
typedef float f32x16 __attribute__((ext_vector_type(16)));
typedef unsigned u32x4 __attribute__((ext_vector_type(4)));
typedef unsigned u32x2 __attribute__((ext_vector_type(2)));
typedef __bf16 bf16x2_t __attribute__((ext_vector_type(2)));

constexpr int NBATCH = 8, SEQ = 2048, TOK = NBATCH * SEQ, DM = 1024, NL = 2;
constexpr int NPROJ = 7168, NEXP = 64, EDIM = 256, TOPK = 8;
constexpr float LN_EPS = 1e-5f, ALPHA = 1.41421356237309515f;
constexpr float QSCALE = 0.125f * 1.4426950408889634f;
constexpr float Y8_SCALE = 16.0f;
constexpr int C_QA = 0, C_QB = 512, C_KB = 1024, C_VB = 1536, C_QC = 2048, C_KC = 2560, C_VC = 3072;
constexpr int C_GA = 3584, C_GB = 4608, C_GC = 5632, C_QI = 6656, C_KA = 6912, C_VA = 6976, C_KI = 7040, C_WI = 7072;

constexpr size_t MiB = 1u << 20;
constexpr size_t WS_CTL = 0, CTL_ZERO_BYTES = 65536;
constexpr size_t CTL_CNT_OFF = 16384;
constexpr size_t WS_MOD = 1 * MiB;
constexpr size_t WS_COS64 = 2 * MiB, WS_SIN64 = WS_COS64 + 262144, WS_COS32 = WS_SIN64 + 262144, WS_SIN32 = WS_COS32 + 131072;
constexpr size_t WS_KMEAN = 3 * MiB;
constexpr size_t WS_TOKE = 3 * MiB + 256 * 1024, WS_TOKP = WS_TOKE + 524288;
constexpr size_t WS_LTOK = 5 * MiB, WS_LW = 9 * MiB;
constexpr size_t WS_WIN = 16 * MiB, WS_WBR = 30 * MiB, WS_WOUT = 33 * MiB, WS_WGU = 36 * MiB, WS_WD = 101 * MiB;
constexpr size_t WS_U = 134 * MiB;
constexpr size_t WS_PROJ = 166 * MiB;
constexpr size_t WS_OABC = 390 * MiB;
constexpr size_t WS_MERGED = 438 * MiB;
constexpr size_t WS_Y = WS_PROJ;
constexpr size_t WS_H = WS_PROJ + 128 * MiB;
constexpr size_t WS_XB = WS_MERGED + (size_t)TOK * DM * 2;
constexpr size_t WS_END = WS_XB + (size_t)TOK * DM * 2;
static_assert(WS_Y + (size_t)131072 * 2048 <= WS_MERGED, "Y overlay");
static_assert(WS_END <= 512 * MiB, "workspace");
static_assert(WS_H + (size_t)(147456 + 256) * 512 <= WS_OABC && WS_Y + (size_t)131072 * 1024 <= WS_H, "H overlay");

constexpr int LDS_MAIN = 133120;
constexpr int LDS_MISC = 133120;
constexpr int LDS_BYTES = LDS_MISC + 2048;
constexpr int NTHREADS = 512;

__device__ __forceinline__ unsigned cvtpk(float lo, float hi) { f32x2 v = {lo, hi}; bf16x2_t b = __builtin_convertvector(v, bf16x2_t); return __builtin_bit_cast(unsigned, b); }
__device__ __forceinline__ float bf2f(unsigned short b) { return __uint_as_float(((unsigned)b) << 16); }
__device__ __forceinline__ float bflo(unsigned w) { return __uint_as_float(w << 16); }
__device__ __forceinline__ float bfhi(unsigned w) { return __uint_as_float(w & 0xffff0000u); }
__device__ __forceinline__ float sigmoidf_(float x) { return __builtin_amdgcn_rcpf(1.0f + __expf(-x)); }
#define GRP_MAJOR(c, G) (((G) == 256) ? ((((c) & 7) << 5) | ((c) >> 3)) : (c))
#define LDS_WAIT() asm volatile("s_waitcnt lgkmcnt(0)" ::: "memory")
#define VM_WAIT() asm volatile("s_waitcnt vmcnt(0)" ::: "memory")

#define XB_TMO      128
#define XB_XCNT(j)  (256  + 64 * (j))
#define XB_XSUB(j)  (1280 + 64 * (j))
#define XB_XGEN(j)  (2304 + 64 * (j))
#define XB_TOP      3328
#define XB_TOPGEN   3392
#define XCD_BAR_WORDS 3456
#define XB_SPIN_CAP (1u << 22)
typedef GAS unsigned gu32;
__device__ __forceinline__ unsigned xb_ld(gu32* p)              { return __hip_atomic_load(p, __ATOMIC_RELAXED, __HIP_MEMORY_SCOPE_AGENT); }
__device__ __forceinline__ unsigned xb_add(gu32* p, unsigned v) { return __hip_atomic_fetch_add(p, v, __ATOMIC_RELAXED, __HIP_MEMORY_SCOPE_AGENT); }
__device__ __forceinline__ unsigned xb_xcc_id() { return (unsigned)__builtin_amdgcn_s_getreg((3 << 11) | 20) & 0xFu; }
#define XB_SPIN(cond, bar) do { unsigned _sp = 0; while (cond) { __builtin_amdgcn_s_sleep(1); \
    if ((++_sp & 255u) == 0u) { if (xb_ld(&(bar)[XB_TMO])) break; if (_sp > XB_SPIN_CAP) { xb_add(&(bar)[XB_TMO], 1u); break; } } } } while (0)
struct XcdBarrier { gu32* bar; unsigned x; volatile LAS unsigned* st; };
#define GB_CNT(g)  (8192 + 64 * (g))
#define GB_XCC(c)  (10240 + (c))
__device__ __forceinline__ void grp_barrier(gu32* ctl_, int g, unsigned target, int wave0, int lane0) {
    gu32* ctl = ctl_; asm volatile("" : "+s"(ctl));
    asm volatile("s_waitcnt vmcnt(0)" ::: "memory");
    __syncthreads();
    if (wave0 == 0 && lane0 == 0) {
        gu32* cnt = ctl + GB_CNT(g);
        (void)__hip_atomic_fetch_add(cnt, 1u, __ATOMIC_RELAXED, __HIP_MEMORY_SCOPE_WORKGROUP);
        unsigned sp = 0;
        while (xb_ld(cnt) < target) { __builtin_amdgcn_s_sleep(1); if (++sp > XB_SPIN_CAP) break; }
        __builtin_amdgcn_fence(__ATOMIC_ACQUIRE, "agent");
        asm volatile("s_waitcnt vmcnt(0)" ::: "memory");
    }
    __syncthreads();
}
__device__ __forceinline__ XcdBarrier xcd_barrier_post(gu32* bar, volatile LAS unsigned* st, bool leader) {
    XcdBarrier b; b.bar = bar; b.x = xb_xcc_id(); b.st = st;
    if (leader) (void)xb_add(&bar[XB_XCNT(b.x)], 1u);
    return b;
}
__device__ __forceinline__ void xcd_barrier_complete(gu32* bar, unsigned x, unsigned& nloc, unsigned& nx) {
    const unsigned G = gridDim.x * gridDim.y * gridDim.z;
    unsigned sum, cnt, mine, sp = 0u;
    for (;;) {
        sum = 0u; cnt = 0u; mine = 0u;
#pragma unroll
        for (unsigned j = 0; j < 16; ++j) { const unsigned c = xb_ld(&bar[XB_XCNT(j)]); sum += c; cnt += (c > 0u) ? 1u : 0u; mine = (j == x) ? c : mine; }
        if (sum == G) break;
        __builtin_amdgcn_s_sleep(1);
        if ((++sp & 255u) == 0u) { if (xb_ld(&bar[XB_TMO])) break; if (sp > XB_SPIN_CAP) { xb_add(&bar[XB_TMO], 1u); break; } }
    }
    nloc = mine > 0u ? mine : 1u; nx = cnt > 0u ? cnt : 1u;
}
__device__ __forceinline__ int lane_id() { unsigned z; asm volatile("s_mov_b32 %0, 0" : "=s"(z)); return (int)__builtin_amdgcn_mbcnt_hi(~0u, __builtin_amdgcn_mbcnt_lo(~0u, z)); }
__device__ __forceinline__ void xcd_barrier_impl(gu32* bar_, unsigned bx, volatile LAS unsigned* st, int wave0) {
    gu32* bar = bar_; asm volatile("" : "+s"(bar));
    asm volatile("s_waitcnt vmcnt(0)" ::: "memory");
    __syncthreads();
    if (wave0 == 0 && lane_id() == 0) {
        __builtin_amdgcn_s_waitcnt(0);
        unsigned nloc = st[0], nx = st[1];
        if (nloc == 0u) { xcd_barrier_complete(bar, bx, nloc, nx); st[0] = nloc; st[1] = nx; }
        const unsigned old = xb_add(&bar[XB_XSUB(bx)], 1u);
        const unsigned gen = old / nloc;
        if (old + 1u == (gen + 1u) * nloc) {
            __builtin_amdgcn_fence(__ATOMIC_RELEASE, "agent");
            asm volatile("s_waitcnt vmcnt(0)" ::: "memory");
            const unsigned og = xb_add(&bar[XB_TOP], 1u);
            const unsigned tg = og / nx;
            if (og + 1u == (tg + 1u) * nx) xb_add(&bar[XB_TOPGEN], 1u);
            else XB_SPIN(xb_ld(&bar[XB_TOPGEN]) == tg, bar);
            __builtin_amdgcn_fence(__ATOMIC_ACQUIRE, "agent");
            xb_add(&bar[XB_XGEN(bx)], 1u);
            asm volatile("s_waitcnt vmcnt(0)" ::: "memory");
        } else {
            XB_SPIN(xb_ld(&bar[XB_XGEN(bx)]) == gen, bar);
            __builtin_amdgcn_fence(__ATOMIC_ACQUIRE, "agent");
            asm volatile("s_waitcnt vmcnt(0)" ::: "memory");
        }
    }
    __syncthreads();
}
__device__ __forceinline__ void xcd_barrier(const XcdBarrier& b, int wave0) { xcd_barrier_impl(b.bar, b.x, b.st, wave0); }

struct Args { const float* in[23]; float* out; unsigned char* ws; int ph_lo, ph_hi; };
struct Frame {
    LAS unsigned char* lds;
    volatile LAS unsigned* MISC;
    int tid, lane, wave, G, bid;
    float* out; unsigned char* ws;
};
#define INP(i) (args.in[(i)])
enum { I_X = 0, I_C, I_ADAW, I_ADAB, I_WIN, I_IKG, I_IKB, I_WBRA, I_WBRB, I_WBRC, I_WOUT, I_LN1G, I_LN1B, I_WR, I_RB, I_WG, I_WU, I_WDN, I_SG, I_SU, I_SD, I_LN2G, I_LN2B };
__device__ __forceinline__ float wave_sum(float v) {
    v += __int_as_float(__builtin_amdgcn_update_dpp(0, __float_as_int(v), 0xB1, 0xF, 0xF, true));
    v += __int_as_float(__builtin_amdgcn_update_dpp(0, __float_as_int(v), 0x4E, 0xF, 0xF, true));
    v += __int_as_float(__builtin_amdgcn_update_dpp(0, __float_as_int(v), 0x141, 0xF, 0xF, true));
    v += __int_as_float(__builtin_amdgcn_update_dpp(0, __float_as_int(v), 0x140, 0xF, 0xF, true));
    const int vi = __float_as_int(v);
    return (__int_as_float(__builtin_amdgcn_readlane(vi, 0)) + __int_as_float(__builtin_amdgcn_readlane(vi, 16))) + (__int_as_float(__builtin_amdgcn_readlane(vi, 32)) + __int_as_float(__builtin_amdgcn_readlane(vi, 48)));
}

__device__ __forceinline__ void ph_ada_rope(Frame& F, const Args& args) {
    LAS float* sc = (LAS float*)F.lds;
    LAS float* part = (LAS float*)(F.lds + 32768);
    const float* c = INP(I_C);
    for (int idx = F.tid; idx < 8192; idx += NTHREADS) { const int k = idx >> 3, b = idx & 7; const float x = c[b * DM + k]; sc[idx] = x / (1.0f + __expf(-x)); }
    __syncthreads();
    float* mod = (float*)(F.ws + WS_MOD);
    for (int item = F.bid; item < 192; item += F.G) {
        const int l = item / 96, n0 = (item % 96) * 64;
        const GAS float* w = (const GAS float*)(INP(I_ADAW)) + (size_t)l * DM * 6144 + n0 + F.lane;
        float acc[8];
#pragma unroll
        for (int b = 0; b < 8; ++b) acc[b] = 0.f;
        const int kb = F.wave * 128;
#pragma unroll 8
        for (int k = 0; k < 128; ++k) {
            const float wv = __builtin_nontemporal_load(w + (size_t)(kb + k) * 6144);
            const f32x4 s0 = *(const LAS f32x4*)(sc + (kb + k) * 8), s1 = *(const LAS f32x4*)(sc + (kb + k) * 8 + 4);
            acc[0] += s0[0] * wv; acc[1] += s0[1] * wv; acc[2] += s0[2] * wv; acc[3] += s0[3] * wv;
            acc[4] += s1[0] * wv; acc[5] += s1[1] * wv; acc[6] += s1[2] * wv; acc[7] += s1[3] * wv;
        }
#pragma unroll
        for (int b = 0; b < 8; ++b) part[(F.wave * 8 + b) * 64 + F.lane] = acc[b];
        __syncthreads();
        { const int b = F.tid >> 6, n = F.tid & 63; float s = 0.f;
#pragma unroll
          for (int w8 = 0; w8 < 8; ++w8) s += part[(w8 * 8 + b) * 64 + n];
          mod[((size_t)l * 8 + b) * 6144 + n0 + n] = s + INP(I_ADAB)[l * 6144 + n0 + n]; }
        __syncthreads();
    }
    { float* c64 = (float*)(F.ws + WS_COS64); float* s64 = (float*)(F.ws + WS_SIN64); float* c32 = (float*)(F.ws + WS_COS32); float* s32 = (float*)(F.ws + WS_SIN32);
      for (int idx = F.bid * NTHREADS + F.tid; idx < SEQ * 48; idx += F.G * NTHREADS) {
          if (idx < SEQ * 32) { const int t = idx >> 5, i = idx & 31; const float inv = powf(10000.0f, -(float)(2 * i) / 64.0f); const float ang = (float)t * inv;
              c64[idx] = (float)cos((double)ang); s64[idx] = (float)sin((double)ang); }
          else { const int j = idx - SEQ * 32; const int t = j >> 4, i = j & 15; const float inv = powf(10000.0f, -(float)(2 * i) / 32.0f); const float ang = (float)t * inv;
              c32[j] = (float)cos((double)ang); s32[j] = (float)sin((double)ang); }
      } }
}

__device__ __forceinline__ int win_src_of_true(int tc) {
    if (tc < 512) return tc;
    if (tc < 1024) return 936 + (tc - 512);
    if (tc < 1536) return 1448 + (tc - 1024);
    if (tc < 2048) return 1960 + (tc - 1536);
    if (tc < 2560) return 2472 + (tc - 2048);
    if (tc < 3072) return 2984 + (tc - 2560);
    if (tc < 3584) return 3496 + (tc - 3072);
    if (tc < 4608) return 4008 + (tc - 3584);
    if (tc < 5632) return 5032 + (tc - 4608);
    if (tc < 6656) return 6056 + (tc - 5632);
    if (tc < 6912) return 640 + (tc - 6656);
    if (tc < 6976) return 512 + (tc - 6912);
    if (tc < 7040) return 576 + (tc - 6976);
    if (tc < 7072) return 896 + (tc - 7040);
    if (tc < 7080) return 928 + (tc - 7072);
    return -1;
}
__device__ __forceinline__ int proj_true_of_gemm(int g) {
    const int pn = g >> 8, gl = g & 255, bj = gl >> 7, wc = (gl >> 5) & 3, y = gl & 31;
    if (pn == 26) return pn * 256 + 32 * (2 * wc + (y >> 4)) + 16 * bj + (y & 15);
    return pn * 256 + 64 * wc + 32 * bj + y;
}
struct CJob { const float* src; bf16_t* dst; int src_ld, k0, scol, dst_ld, n0; };
__device__ __forceinline__ void conv_load(const CJob& j, f32x4 (&v)[16], int lane) {
    const int rq = lane >> 4;
    const GAS float* sp = (const GAS float*)j.src + (size_t)(j.k0 + rq) * j.src_ld + (j.scol < 0 ? 0 : j.scol);
#pragma unroll
    for (int i = 0; i < 16; ++i) v[i] = (j.scol < 0) ? (f32x4){0.f, 0.f, 0.f, 0.f} : __builtin_nontemporal_load((const GAS f32x4*)(sp + (size_t)(4 * i) * j.src_ld));
}
__device__ __forceinline__ void conv_store(const CJob& j, const f32x4 (&v)[16], LAS float* scr, int lane) {
    const int rq = lane >> 4, c4 = (lane & 15) * 4;
#pragma unroll
    for (int i = 0; i < 16; ++i) { const int k = 4 * i + rq;
#pragma unroll
        for (int jj = 0; jj < 4; ++jj) scr[(c4 + jj) * 65 + k] = v[i][jj]; }
    LDS_WAIT();
#pragma unroll
    for (int i = 0; i < 8; ++i) { const int n = (lane >> 3) + 8 * i, c = lane & 7; const LAS float* sp = scr + n * 65 + 8 * c;
        u32x4 o; o.x = cvtpk(sp[0], sp[1]); o.y = cvtpk(sp[2], sp[3]); o.z = cvtpk(sp[4], sp[5]); o.w = cvtpk(sp[6], sp[7]);
        *(GAS u32x4*)(j.dst + (size_t)(j.n0 + n) * j.dst_ld + j.k0 + 8 * c) = o; }
    LDS_WAIT();
}
constexpr int CT_WIN = 16 * 112, CT_WBR = 3 * 8 * 16, CT_WOUT = 256, CT_WGU = 65 * 16 * 8, CT_WD = 65 * 4 * 16, CT_ALL = CT_WIN + CT_WBR + CT_WOUT + CT_WGU + CT_WD;
__device__ __forceinline__ void conv_kn(int r, int NB, int& kb, int& nb) { const int grp = r >> 3, w8 = r & 7, nbg = NB >> 2; kb = 2 * (grp / nbg) + (w8 >> 2); nb = 4 * (grp % nbg) + (w8 & 3); }
__device__ __forceinline__ CJob conv_job(const Args& args, unsigned char* ws, int l, int it, int lane) {
    const int c4 = (lane & 15) * 4; CJob j; int r = it;
    if (r < CT_WIN) { int kb, nb; conv_kn(r, 112, kb, nb); const int g = nb * 64 + c4;
        j.src = INP(I_WIN) + (size_t)l * DM * 7080; j.src_ld = 7080; j.k0 = kb * 64; j.scol = win_src_of_true(proj_true_of_gemm(g)); j.dst = (bf16_t*)(ws + WS_WIN); j.dst_ld = DM; j.n0 = nb * 64; return j; }
    r -= CT_WIN;
    if (r < CT_WBR) { const int br = r / 128, q = r % 128; int kb, nb; conv_kn(q, 16, kb, nb);
        j.src = (br == 0 ? INP(I_WBRA) : (br == 1 ? INP(I_WBRB) : INP(I_WBRC))) + (size_t)l * 512 * DM; j.src_ld = DM; j.k0 = kb * 64; j.scol = nb * 64 + c4;
        j.dst = (bf16_t*)(ws + WS_WBR) + (size_t)br * DM * 512; j.dst_ld = 512; j.n0 = nb * 64; return j; }
    r -= CT_WBR;
    if (r < CT_WOUT) { int kb, nb; conv_kn(r, 16, kb, nb);
        j.src = INP(I_WOUT) + (size_t)l * DM * DM; j.src_ld = DM; j.k0 = kb * 64; j.scol = nb * 64 + c4; j.dst = (bf16_t*)(ws + WS_WOUT); j.dst_ld = DM; j.n0 = nb * 64; return j; }
    r -= CT_WOUT;
    if (r < CT_WGU) { const int e = r / 128, q = r % 128; int kb, nb; conv_kn(q, 8, kb, nb);
        const int g = nb * 64 + c4, pn = g >> 8, bj = (g >> 7) & 1, x = g & 127, f = 128 * pn + x;
        j.src = (e < 64) ? ((bj ? INP(I_WU) : INP(I_WG)) + ((size_t)l * 64 + e) * DM * EDIM) : ((bj ? INP(I_SU) : INP(I_SG)) + (size_t)l * DM * EDIM);
        j.src_ld = EDIM; j.k0 = kb * 64; j.scol = f; j.dst = (bf16_t*)(ws + WS_WGU) + (size_t)e * 512 * DM; j.dst_ld = DM; j.n0 = nb * 64; return j; }
    r -= CT_WGU;
    { const int e = r / 64, q = r % 64; int kb, nb; conv_kn(q, 16, kb, nb);
        const int g = nb * 64 + c4, tn = (g & ~255) + 64 * ((g >> 5) & 3) + 16 * ((g >> 3) & 3) + 8 * ((g >> 7) & 1) + (g & 7);
        j.src = (e < 64) ? (INP(I_WDN) + ((size_t)l * 64 + e) * EDIM * DM) : (INP(I_SD) + (size_t)l * EDIM * DM);
        j.src_ld = DM; j.k0 = kb * 64; j.scol = tn; j.dst = (bf16_t*)(ws + WS_WD) + (size_t)e * DM * EDIM; j.dst_ld = EDIM; j.n0 = nb * 64; return j; }
}
__device__ __forceinline__ void ph_convert(Frame& F, const Args& args, int l) {
    LAS float* scr = (LAS float*)(F.lds + F.wave * 16640);
    const int gw = F.bid * 8 + F.wave, NGW = F.G * 8, lane = F.lane;
    int it = gw;
    if (it >= CT_ALL) return;
    CJob cur = conv_job(args, F.ws, l, it, lane);
    f32x4 va[16], vb[16];
    conv_load(cur, va, lane);
    for (;;) {
        const int it2 = it + NGW; const bool more = it2 < CT_ALL;
        CJob nxt = cur;
        if (more) { nxt = conv_job(args, F.ws, l, it2, lane); conv_load(nxt, vb, lane); }
        conv_store(cur, va, scr, lane);
        if (!more) break;
        const int it3 = it2 + NGW; const bool more2 = it3 < CT_ALL;
        cur = nxt;
        if (more2) { cur = conv_job(args, F.ws, l, it3, lane); conv_load(cur, va, lane); }
        conv_store(nxt, vb, scr, lane);
        if (!more2) break;
        it = it3;
    }
}

__device__ __forceinline__ void ph_modulate(Frame& F, const float* x, int l) {
    const float* mod = (const float*)(F.ws + WS_MOD) + (size_t)l * 8 * 6144;
    bf16_t* U = (bf16_t*)(F.ws + WS_U);
    for (int blk0_ = F.bid; blk0_ < TOK / 64; blk0_ += F.G)
    for (int m = GRP_MAJOR(blk0_, F.G) * 64 + F.wave; m < GRP_MAJOR(blk0_, F.G) * 64 + 64; m += 8) {
        const int b = m >> 11; const GAS f32x4* xr = (const GAS f32x4*)(x + (size_t)m * DM) + F.lane;
        const GAS f32x4* sh = (const GAS f32x4*)(mod + b * 6144) + F.lane; const GAS f32x4* sc = (const GAS f32x4*)(mod + b * 6144 + DM) + F.lane;
        GAS u32x2* o = (GAS u32x2*)(U + (size_t)m * DM) + F.lane;
#pragma unroll
        for (int j = 0; j < 4; ++j) { const f32x4 v = __builtin_nontemporal_load(xr + 64 * j), a = sc[64 * j], s = sh[64 * j]; const f32x4 u = v * (1.0f + a) + s;
            u32x2 w; w.x = cvtpk(u[0], u[1]); w.y = cvtpk(u[2], u[3]); o[64 * j] = w; }
    }
}
constexpr int RT_PITCH = 4096 + 16;
template <bool XF32>
__device__ __forceinline__ void ph_ln1(Frame& F, const Args& args, const float* x, int l, int m_lo, int m_hi, int m_step, LAS unsigned char* stage, int m_base) {
    const float* mod = (const float*)(F.ws + WS_MOD) + (size_t)l * 8 * 6144;
    const bf16_t* Yb = (const bf16_t*)(F.ws + WS_OABC);
    bf16_t* U = (bf16_t*)(F.ws + WS_U); bf16_t* XB = (bf16_t*)(F.ws + WS_XB);
    const GAS f32x4* lg = (const GAS f32x4*)(INP(I_LN1G) + l * DM) + F.lane; const GAS f32x4* lb = (const GAS f32x4*)(INP(I_LN1B) + l * DM) + F.lane;
#pragma unroll 2
    for (int m = m_lo; m < m_hi; m += m_step) {
        const int b = m >> 11; const GAS f32x4* xr = (const GAS f32x4*)(x + (size_t)m * DM) + F.lane;
        const GAS u32x2* xbr = (const GAS u32x2*)(XB + (size_t)m * DM) + F.lane;
        const GAS f32x4* g1 = (const GAS f32x4*)(mod + b * 6144 + 2 * DM) + F.lane;
        const GAS f32x4* sh2 = (const GAS f32x4*)(mod + b * 6144 + 3 * DM) + F.lane; const GAS f32x4* sc2 = (const GAS f32x4*)(mod + b * 6144 + 4 * DM) + F.lane;
        f32x4 v[4]; float s = 0.f;
#pragma unroll
        for (int j = 0; j < 4; ++j) { f32x4 y = {0.f, 0.f, 0.f, 0.f};
            if (EN_MIX) { const u32x2 yw = __builtin_nontemporal_load((const GAS u32x2*)(Yb + (size_t)(j >> 1) * TOK * 512 + (size_t)m * 512) + F.lane + 64 * (j & 1)); y = (f32x4){bflo(yw.x), bfhi(yw.x), bflo(yw.y), bfhi(yw.y)}; }
            f32x4 xv;
            if (XF32) xv = __builtin_nontemporal_load(xr + 64 * j); else { const u32x2 xw = __builtin_nontemporal_load(xbr + 64 * j); xv = (f32x4){bflo(xw.x), bfhi(xw.x), bflo(xw.y), bfhi(xw.y)}; }
            v[j] = xv * ALPHA + (1.0f + g1[64 * j]) * y; s += (v[j][0] + v[j][1]) + (v[j][2] + v[j][3]); }
        const float mean = wave_sum(s) * (1.f / DM); float s2 = 0.f;
#pragma unroll
        for (int j = 0; j < 4; ++j) { v[j] = v[j] - mean; s2 += (v[j][0] * v[j][0] + v[j][1] * v[j][1]) + (v[j][2] * v[j][2] + v[j][3] * v[j][3]); }
        const float rstd = 1.f / sqrtf(wave_sum(s2) * (1.f / DM) + LN_EPS);
        GAS u32x2* xo = (GAS u32x2*)(XB + (size_t)m * DM) + F.lane; GAS u32x2* uo = (GAS u32x2*)(U + (size_t)m * DM) + F.lane;
        LAS f32x4* so = (LAS f32x4*)(stage + (m - m_base) * RT_PITCH) + F.lane;
#pragma unroll
        for (int j = 0; j < 4; ++j) { const f32x4 x1 = v[j] * rstd * lg[64 * j] + lb[64 * j]; u32x2 xw; xw.x = cvtpk(x1[0], x1[1]); xw.y = cvtpk(x1[2], x1[3]); xo[64 * j] = xw;
            const f32x4 u = x1 * (1.0f + sc2[64 * j]) + sh2[64 * j]; u32x2 w; w.x = cvtpk(u[0], u[1]); w.y = cvtpk(u[2], u[3]); uo[64 * j] = w; so[64 * j] = u; }
    }
}
__device__ __forceinline__ void load_expert_tables(Frame& F, int l) {
    if (F.tid == 0) {
        const unsigned* cnt = (const unsigned*)(F.ws + WS_CTL + CTL_CNT_OFF) + l * 64;
        unsigned so = 0, to = 0;
        for (int e = 0; e < 64; ++e) { const unsigned c = __hip_atomic_load(cnt + e, __ATOMIC_RELAXED, __HIP_MEMORY_SCOPE_AGENT); F.MISC[32 + e] = so; F.MISC[128 + e] = to; F.MISC[256 + e] = c; so += c; to += (c + 255u) >> 8; }
        F.MISC[32 + 64] = 131072u; F.MISC[128 + 64] = to; F.MISC[128 + 65] = to + 64u; F.MISC[256 + 64] = TOK;
    }
    __syncthreads();
}
__device__ __forceinline__ void ph_combine(Frame& F, const Args& args, int l) {
    load_expert_tables(F, l);
    const float* mod = (const float*)(F.ws + WS_MOD) + (size_t)l * 8 * 6144;
    const float* modn = (const float*)(F.ws + WS_MOD) + (size_t)(l + 1) * 8 * 6144;
    const unsigned char* Y8 = F.ws + WS_Y; bf16_t* U = (bf16_t*)(F.ws + WS_U);
    const int* toke = (const int*)(F.ws + WS_TOKE); const int* tokp = (const int*)(F.ws + WS_TOKP);
    const GAS f32x4* lg = (const GAS f32x4*)(INP(I_LN2G) + l * DM) + 4 * F.lane; const GAS f32x4* lb = (const GAS f32x4*)(INP(I_LN2B) + l * DM) + 4 * F.lane;
    const int gw = F.bid * 8 + F.wave, NGW = F.G * 8;
    typedef float f32x2v __attribute__((ext_vector_type(2)));
#pragma unroll 2
    for (int m = gw; m < TOK; m += NGW) {
        const int b = m >> 11;
        int es[8], ps[8];
#pragma unroll
        for (int k = 0; k < TOPK; ++k) { es[k] = __builtin_amdgcn_readfirstlane(toke[m * 8 + k]); ps[k] = __builtin_amdgcn_readfirstlane(tokp[m * 8 + k]); }
        f32x4 racc[4];
#pragma unroll
        for (int j = 0; j < 4; ++j) racc[j] = (f32x4){0.f, 0.f, 0.f, 0.f};
#pragma unroll
        for (int k = 0; k < TOPK; ++k) {
            const size_t slot = (size_t)F.MISC[32 + es[k]] + (size_t)ps[k];
            const u32x4 w = __builtin_nontemporal_load((const GAS u32x4*)(Y8 + slot * DM) + F.lane);
#pragma unroll
            for (int j = 0; j < 4; ++j) { const f32x2v lo = __builtin_amdgcn_cvt_pk_f32_fp8((int)w[j], false), hi = __builtin_amdgcn_cvt_pk_f32_fp8((int)w[j], true);
                racc[j] += (f32x4){lo[0], lo[1], hi[0], hi[1]}; }
        }
        f32x4 acc[4];
        { const GAS u32x4* ys = (const GAS u32x4*)(U + (size_t)m * DM) + 2 * F.lane; const u32x4 w0 = __builtin_nontemporal_load(ys), w1 = __builtin_nontemporal_load(ys + 1);
          acc[0] = (f32x4){bflo(w0.x), bfhi(w0.x), bflo(w0.y), bfhi(w0.y)}; acc[1] = (f32x4){bflo(w0.z), bfhi(w0.z), bflo(w0.w), bfhi(w0.w)};
          acc[2] = (f32x4){bflo(w1.x), bfhi(w1.x), bflo(w1.y), bfhi(w1.y)}; acc[3] = (f32x4){bflo(w1.z), bfhi(w1.z), bflo(w1.w), bfhi(w1.w)}; }
#pragma unroll
        for (int j = 0; j < 4; ++j) acc[j] += racc[j] * (1.0f / Y8_SCALE);
        f32x4 xr[4];
        { const GAS u32x4* xs = (const GAS u32x4*)((const bf16_t*)(F.ws + WS_XB) + (size_t)m * DM) + 2 * F.lane; const u32x4 w0 = __builtin_nontemporal_load(xs), w1 = __builtin_nontemporal_load(xs + 1);
          xr[0] = (f32x4){bflo(w0.x), bfhi(w0.x), bflo(w0.y), bfhi(w0.y)}; xr[1] = (f32x4){bflo(w0.z), bfhi(w0.z), bflo(w0.w), bfhi(w0.w)};
          xr[2] = (f32x4){bflo(w1.x), bfhi(w1.x), bflo(w1.y), bfhi(w1.y)}; xr[3] = (f32x4){bflo(w1.z), bfhi(w1.z), bflo(w1.w), bfhi(w1.w)}; }
        const GAS f32x4* g2 = (const GAS f32x4*)(mod + b * 6144 + 5 * DM) + 4 * F.lane;
        f32x4 v[4]; float s = 0.f;
#pragma unroll
        for (int j = 0; j < 4; ++j) { v[j] = xr[j] * ALPHA + (1.0f + g2[j]) * acc[j]; s += (v[j][0] + v[j][1]) + (v[j][2] + v[j][3]); }
        const float mean = wave_sum(s) * (1.f / DM); float s2 = 0.f;
#pragma unroll
        for (int j = 0; j < 4; ++j) { v[j] = v[j] - mean; s2 += (v[j][0] * v[j][0] + v[j][1] * v[j][1]) + (v[j][2] * v[j][2] + v[j][3] * v[j][3]); }
        const float rstd = 1.f / sqrtf(wave_sum(s2) * (1.f / DM) + LN_EPS);
        GAS f32x4* xo = (GAS f32x4*)(F.out + (size_t)m * DM) + 4 * F.lane; GAS u32x4* uo = (GAS u32x4*)(U + (size_t)m * DM) + 2 * F.lane;
        f32x4 un[4];
#pragma unroll
        for (int j = 0; j < 4; ++j) { const f32x4 x2 = v[j] * rstd * lg[j] + lb[j]; if (l + 1 >= NL) xo[j] = x2; un[j] = x2; xr[j] = x2;
            if (l + 1 < NL) { const f32x4 sh = *((const GAS f32x4*)(modn + b * 6144) + 4 * F.lane + j), sc = *((const GAS f32x4*)(modn + b * 6144 + DM) + 4 * F.lane + j); un[j] = x2 * (1.0f + sc) + sh; } }
        if (l + 1 < NL) { u32x4 w0, w1;
            w0.x = cvtpk(un[0][0], un[0][1]); w0.y = cvtpk(un[0][2], un[0][3]); w0.z = cvtpk(un[1][0], un[1][1]); w0.w = cvtpk(un[1][2], un[1][3]);
            w1.x = cvtpk(un[2][0], un[2][1]); w1.y = cvtpk(un[2][2], un[2][3]); w1.z = cvtpk(un[3][0], un[3][1]); w1.w = cvtpk(un[3][2], un[3][3]);
            uo[0] = w0; uo[1] = w1;
            GAS u32x4* xbo = (GAS u32x4*)((bf16_t*)(F.ws + WS_XB) + (size_t)m * DM) + 2 * F.lane;
            w0.x = cvtpk(xr[0][0], xr[0][1]); w0.y = cvtpk(xr[0][2], xr[0][3]); w0.z = cvtpk(xr[1][0], xr[1][1]); w0.w = cvtpk(xr[1][2], xr[1][3]);
            w1.x = cvtpk(xr[2][0], xr[2][1]); w1.y = cvtpk(xr[2][2], xr[2][3]); w1.z = cvtpk(xr[3][0], xr[3][1]); w1.w = cvtpk(xr[3][2], xr[3][3]);
            xbo[0] = w0; xbo[1] = w1; }
    }
}

__device__ __forceinline__ void ph_router(Frame& F, const Args& args, const float* xin, int l) {
    const float* mod = (const float*)(F.ws + WS_MOD) + (size_t)l * 8 * 6144;
    const float* Wr = INP(I_WR) + (size_t)l * DM * 64;
    const float* rb = INP(I_RB) + l * 64;
    unsigned* gcnt = (unsigned*)(F.ws + WS_CTL + CTL_CNT_OFF) + l * 64;
    int* toke = (int*)(F.ws + WS_TOKE); int* tokp = (int*)(F.ws + WS_TOKP);
    int* ltok = (int*)(F.ws + WS_LTOK); float* lw = (float*)(F.ws + WS_LW);
    LAS float* part = (LAS float*)F.lds;
    volatile LAS unsigned* lcnt = F.MISC + 384;
    const int lane = F.lane, i = lane & 31, kk = lane >> 5;
    for (int item0_ = F.bid; item0_ < TOK / 64; item0_ += F.G) {
        const int item = GRP_MAJOR(item0_, F.G);
        const int t0 = item * 64, b = t0 >> 11;
        f32x16 acc[2][2];
#pragma unroll
        for (int a = 0; a < 2; ++a)
#pragma unroll
            for (int c = 0; c < 2; ++c)
#pragma unroll
                for (int r = 0; r < 16; ++r) acc[a][c][r] = 0.f;
        const int kb = F.wave * 128;
#pragma unroll
        for (int rt = 0; rt < 2; ++rt) {
            if (l == 0) ph_ln1<true>(F, args, xin, l, t0 + 32 * rt + F.wave, t0 + 32 * rt + 32, 8, F.lds, t0 + 32 * rt);
            else ph_ln1<false>(F, args, xin, l, t0 + 32 * rt + F.wave, t0 + 32 * rt + 32, 8, F.lds, t0 + 32 * rt);
            __syncthreads();
#pragma unroll 4
            for (int it = 0; it < 16; ++it) {
                const int k4 = kb + 8 * it + 4 * kk;
                const f32x4 a4 = *(const LAS f32x4*)(F.lds + i * RT_PITCH + 4 * k4);
                float bv[2][4];
#pragma unroll
                for (int s = 0; s < 4; ++s) { bv[0][s] = ((const GAS float*)Wr)[(size_t)(k4 + s) * 64 + i]; bv[1][s] = ((const GAS float*)Wr)[(size_t)(k4 + s) * 64 + 32 + i]; }
#pragma unroll
                for (int s = 0; s < 4; ++s)
#pragma unroll
                    for (int ct = 0; ct < 2; ++ct) acc[rt][ct] = __builtin_amdgcn_mfma_f32_32x32x2f32(a4[s], bv[ct][s], acc[rt][ct], 0, 0, 0);
            }
            __syncthreads();
        }
#pragma unroll
        for (int rt = 0; rt < 2; ++rt)
#pragma unroll
            for (int ct = 0; ct < 2; ++ct)
#pragma unroll
                for (int r = 0; r < 16; ++r) { const int tk = 32 * rt + (r & 3) + 8 * (r >> 2) + 4 * kk; part[(F.wave * 64 + tk) * 65 + 32 * ct + i] = acc[rt][ct][r]; }
        if (F.tid < 64) lcnt[F.tid] = 0u;
        __syncthreads();
        const int tk = F.tid >> 3, eg = F.tid & 7, t = t0 + tk;
        float sg[8], bs[8];
#pragma unroll
        for (int j = 0; j < 8; ++j) { float s = 0.f;
#pragma unroll
            for (int w8 = 0; w8 < 8; ++w8) s += part[(w8 * 64 + tk) * 65 + 8 * eg + j];
            sg[j] = sigmoidf_(s); bs[j] = sg[j] + rb[8 * eg + j]; }
        float m1 = -INFINITY, m2 = -INFINITY;
#pragma unroll
        for (int j = 0; j < 8; ++j) { const float v = bs[j]; if (v > m1) { m2 = m1; m1 = v; } else if (v > m2) m2 = v; }
        const float gs = m1 + m2;
        int grank = 0;
#pragma unroll 1
        for (int d = 0; d < 8; ++d) { const float og = __shfl(gs, (lane & ~7) + d); grank += (og > gs || (og == gs && d < eg)) ? 1 : 0; }
        const bool gsel = grank < 4;
        float cv[8];
#pragma unroll
        for (int j = 0; j < 8; ++j) cv[j] = gsel ? bs[j] : -INFINITY;
        int rank[8];
#pragma unroll
        for (int j = 0; j < 8; ++j) rank[j] = 0;
#pragma unroll 1
        for (int d = 0; d < 8; ++d)
#pragma unroll
            for (int jj = 0; jj < 8; ++jj) { const float ov = __shfl(cv[jj], (lane & ~7) + d); const int oi = 8 * d + jj;
#pragma unroll
                for (int j = 0; j < 8; ++j) rank[j] += (ov > cv[j] || (ov == cv[j] && oi < 8 * eg + j)) ? 1 : 0; }
        unsigned selm = 0; float wsum = 0.f;
#pragma unroll
        for (int j = 0; j < 8; ++j) { const bool s = gsel && rank[j] < TOPK; selm |= s ? (1u << j) : 0u; wsum += s ? sg[j] : 0.f; }
        wsum += __shfl_xor(wsum, 1); wsum += __shfl_xor(wsum, 2); wsum += __shfl_xor(wsum, 4);
        const int nsel = __popc(selm); int pre = 0;
#pragma unroll 1
        for (int d = 0; d < 8; ++d) { const int on = __shfl(nsel, (lane & ~7) + d); pre += (d < eg) ? on : 0; }
        const float wscale = 2.5f / wsum;
        int lp[8];
#pragma unroll
        for (int j = 0; j < 8; ++j) { lp[j] = 0; if (selm & (1u << j)) lp[j] = (int)atomicAdd((unsigned*)(lcnt + 8 * eg + j), 1u); }
        __syncthreads();
        if (F.tid < 64) lcnt[64 + F.tid] = atomicAdd(gcnt + F.tid, lcnt[F.tid]);
        __syncthreads();
        int kslot = pre;
#pragma unroll
        for (int j = 0; j < 8; ++j) if (selm & (1u << j)) { const int e = 8 * eg + j; const int pos = (int)lcnt[64 + e] + lp[j];
            toke[t * 8 + kslot] = e; tokp[t * 8 + kslot] = pos; ltok[e * TOK + pos] = t; lw[e * TOK + pos] = sg[j] * wscale; ++kslot; }
        __syncthreads();
    }
}

namespace pg8 {
constexpr int BM = 256, BK = 64, HALF = 128, HTB = HALF * BK * 2, STAGE_BYTES = 8 * HTB, NXCD = 8, WGM = 8;
__host__ __device__ __forceinline__ int lds_byte(int r, int c) { const int st = (r >> 4) * 2 + (c >> 5), rr = r & 15, cc = c & 31, ob = rr * 64 + cc * 2; return st * 1024 + (ob ^ (((ob >> 9) & 1) << 5)); }
__host__ __device__ __forceinline__ void stage_rc(int b, int& R, int& C) { const int st = b / 1024, sb = b % 1024, swz = sb ^ (((sb >> 9) & 1) << 5); R = (st >> 1) * 16 + swz / 64; C = (st & 1) * 32 + (swz % 64) / 2; }
__host__ __device__ __forceinline__ int perm32(int rho) { const int n = rho >> 4, i = rho & 15; return 8 * (i >> 2) + 4 * n + (i & 3); }
struct Unit { int pm, pn, e; };
__device__ __forceinline__ bool static_tile(int L, int nM, int nN, int& pm, int& pn) {
    const int nwg = nM * nN; if (L >= nwg) return false;
    int wgid = L; { const int q = nwg / NXCD, r = nwg % NXCD, xcd = wgid % NXCD, off = wgid / NXCD; wgid = (xcd < r ? xcd * (q + 1) : r * (q + 1) + (xcd - r) * q) + off; }
    const int nig = WGM * nN, gid = wgid / nig, fm = gid * WGM, gsz = (nM - fm) < WGM ? (nM - fm) : WGM;
    pm = fm + ((wgid % nig) % gsz); pn = (wgid % nig) / gsz; return true;
}
template <class T, class = void> struct epi_chain { static constexpr bool value = false; };
template <class T> struct epi_chain<T, decltype((void)T::CHAIN)> { static constexpr bool value = T::CHAIN; };
template <class P, class Epi>
__device__ __forceinline__ void gemm_phase(LAS unsigned char* lds, const P& S, const Epi& E, int tid) {
    constexpr bool GA = P::GATHER;
    const int wid = __builtin_amdgcn_readfirstlane(tid >> 6), lane = tid & 63, wr = wid >> 2, wc = wid & 3, fr = lane & 15, fq = lane >> 4;
    const int K = S.K, nt = K / BK;
    unsigned voffB[2], va[2];
#pragma unroll
    for (int i = 0; i < 2; ++i) { int R, C; stage_rc(tid * 16 + i * 8192, R, C); const int Rb = (R & ~31) + perm32(R & 31); voffB[i] = (unsigned)(Rb * K + C) * 2u; va[i] = (unsigned)(R * K + C) * 2u; }
    const size_t kstep = (size_t)(BK * 2);
    const size_t hstepB = (size_t)HALF * K * 2;
    const size_t hstepA = GA ? (size_t)0 : hstepB;
    const unsigned ldsw = (unsigned)wid * 1024u;
    const int aoff = lds_byte(wr * 64 + fr, fq * 8), boff = lds_byte(wc * 32 + fr, fq * 8);
#define PG8_SA(b, h) (((b) * 2 + (h)) * HTB)
#define PG8_SB(b, h) ((4 + (b) * 2 + (h)) * HTB)
#define PG8_STAGE2(bufoff, gbase, v0, v1) do { \
        __builtin_amdgcn_global_load_lds((const unsigned*)((const char*)(gbase) + (v0)), (LAS unsigned*)(lds + (bufoff) + ldsw), 16, 0, 0); \
        __builtin_amdgcn_global_load_lds((const unsigned*)((const char*)(gbase) + (v1)), (LAS unsigned*)(lds + (bufoff) + ldsw + 8192), 16, 0, 0); } while (0)
#define PG8_STAGEB(bufoff, gbase) PG8_STAGE2(bufoff, gbase, voffB[0], voffB[1])
#define PG8_STAGEA(bufoff, gbase, h, nx) do { if constexpr (GA) { const unsigned _v0 = (nx) ? nv[h][0] : cv[h][0], _v1 = (nx) ? nv[h][1] : cv[h][1]; PG8_STAGE2(bufoff, gbase, _v0, _v1); } \
        else { PG8_STAGE2(bufoff, (gbase) + (h) * hstepA, va[0], va[1]); } } while (0)
#define PG8_LDA(dst, b, h) do { _Pragma("unroll") for (int m = 0; m < 4; ++m) _Pragma("unroll") for (int k = 0; k < 2; ++k) dst[m][k] = *(const LAS bf16x8*)(lds + PG8_SA(b, h) + aoff + m * 2048 + k * 1024); } while (0)
#define PG8_LDB(dst, b, h) do { _Pragma("unroll") for (int n = 0; n < 2; ++n) _Pragma("unroll") for (int k = 0; k < 2; ++k) dst[n][k] = *(const LAS bf16x8*)(lds + PG8_SB(b, h) + boff + n * 2048 + k * 1024); } while (0)
#define PG8_MMA(ai, bj, At, Bt) do { __builtin_amdgcn_s_setprio(1); _Pragma("unroll") for (int m = 0; m < 4; ++m) _Pragma("unroll") for (int n = 0; n < 2; ++n) _Pragma("unroll") for (int k = 0; k < 2; ++k) \
        acc[ai][bj][m][n] = __builtin_amdgcn_mfma_f32_16x16x32_bf16(Bt[n][k], At[m][k], acc[ai][bj][m][n], 0, 0, 0); __builtin_amdgcn_s_setprio(0); } while (0)
#define PG8_WAIT_V(n) asm volatile("s_waitcnt vmcnt(" #n ")" ::: "memory")
#define PG8_WAIT_L(n) asm volatile("s_waitcnt lgkmcnt(" #n ")" ::: "memory")
#define PG8_BAR __builtin_amdgcn_s_barrier()
#define PG8_SCHED __builtin_amdgcn_sched_barrier(0)
    Unit cur, nxt; int ui = 0;
    if (!S.next(0, cur)) return;
    f32x4 acc[2][2][4][2];
#pragma unroll
    for (int a = 0; a < 2; ++a)
#pragma unroll
        for (int b = 0; b < 2; ++b)
#pragma unroll
            for (int m = 0; m < 4; ++m)
#pragma unroll
                for (int n = 0; n < 2; ++n) acc[a][b][m][n] = (f32x4){0.f, 0.f, 0.f, 0.f};
    bf16x8 At[4][2], B0[2][2], B1[2][2];
    const char* cA = S.a_base(cur); const char* cB = S.b_base(cur);
    unsigned cv[2][2], nv[2][2];
    if constexpr (GA) { S.a_voff(cur, cv);
#pragma unroll
        for (int h = 0; h < 2; ++h)
#pragma unroll
            for (int i = 0; i < 2; ++i) nv[h][i] = cv[h][i]; }
    PG8_STAGEB(PG8_SB(0, 0), cB); PG8_STAGEB(PG8_SB(0, 1), cB + hstepB); PG8_STAGEA(PG8_SA(0, 0), cA, 0, false); PG8_STAGEA(PG8_SA(0, 1), cA, 1, false);
    if (wr == 1) PG8_BAR;
    PG8_WAIT_V(2); PG8_BAR;
    PG8_STAGEB(PG8_SB(1, 0), cB + kstep); PG8_STAGEA(PG8_SA(1, 0), cA + kstep, 0, false); PG8_STAGEB(PG8_SB(1, 1), cB + hstepB + kstep);
    PG8_WAIT_V(6); PG8_BAR;
    for (;;) {
        const bool has_next = S.next(ui + 1, nxt);
        const char* nA = cA; const char* nB = cB;
        if (has_next) { nA = S.a_base(nxt); nB = S.b_base(nxt); if constexpr (GA) S.a_voff(nxt, nv); }
        for (int t = 0; t < nt; t += 2) {
            const bool last = (t == nt - 2);
            const char* a1 = cA + (size_t)(t + 1) * kstep;
            const char* a2 = last ? nA : cA + (size_t)(t + 2) * kstep; const char* b2 = last ? nB : cB + (size_t)(t + 2) * kstep;
            const char* a3 = a2 + kstep; const char* b3 = b2 + kstep;
            const int relax_i = __builtin_amdgcn_readfirstlane(((Epi::NST > 0) && (t == 0) && (ui > 0)) ? 1 : 0);
            PG8_LDB(B0, 0, 0); PG8_LDB(B1, 0, 1); PG8_SCHED; PG8_LDA(At, 0, 0); PG8_STAGEA(PG8_SA(1, 1), a1, 1, false);
            if constexpr (Epi::NST == 16) { asm volatile("s_cmp_eq_u32 %0, 0\n\ts_cbranch_scc1 1f\n\ts_waitcnt vmcnt(24)\n\ts_branch 2f\n1:\n\ts_waitcnt vmcnt(8)\n2:" :: "s"(relax_i) : "scc", "memory"); } else PG8_WAIT_V(8);
            PG8_WAIT_L(0); PG8_BAR; PG8_MMA(0, 0, At, B0); PG8_MMA(0, 1, At, B1); PG8_BAR; PG8_SCHED;
            PG8_LDA(At, 0, 1); PG8_STAGEB(PG8_SB(0, 0), b2); PG8_STAGEB(PG8_SB(0, 1), b2 + hstepB); PG8_STAGEA(PG8_SA(0, 0), a2, 0, last);
            if constexpr (Epi::NST == 16) { asm volatile("s_cmp_eq_u32 %0, 0\n\ts_cbranch_scc1 1f\n\ts_waitcnt vmcnt(24)\n\ts_branch 2f\n1:\n\ts_waitcnt vmcnt(8)\n2:" :: "s"(relax_i) : "scc", "memory"); } else PG8_WAIT_V(8);
            PG8_WAIT_L(0); PG8_BAR; PG8_MMA(1, 0, At, B0); PG8_MMA(1, 1, At, B1); PG8_BAR; PG8_SCHED;
            PG8_LDB(B0, 1, 0); PG8_LDB(B1, 1, 1); PG8_SCHED; PG8_LDA(At, 1, 0); PG8_STAGEA(PG8_SA(0, 1), a2, 1, last);
            PG8_WAIT_V(8); PG8_WAIT_L(0); PG8_BAR; PG8_MMA(0, 0, At, B0); PG8_MMA(0, 1, At, B1); PG8_BAR; PG8_SCHED;
            PG8_LDA(At, 1, 1); PG8_STAGEB(PG8_SB(1, 0), b3); PG8_STAGEB(PG8_SB(1, 1), b3 + hstepB); PG8_STAGEA(PG8_SA(1, 0), a3, 0, last);
            PG8_WAIT_V(8); PG8_WAIT_L(0); PG8_BAR; PG8_MMA(1, 0, At, B0); PG8_MMA(1, 1, At, B1); PG8_BAR; PG8_SCHED;
        }
        if (wr == 0) PG8_BAR;
        { const int le = lane_id(); E(acc, cur, wr, wc, le & 15, le >> 4); }
        if (!has_next) break;
        bool carry = false;
        if constexpr (epi_chain<Epi>::value) carry = (cur.e < 2);
        if (!carry) {
#pragma unroll
        for (int a = 0; a < 2; ++a)
#pragma unroll
            for (int b = 0; b < 2; ++b)
#pragma unroll
                for (int m = 0; m < 4; ++m)
#pragma unroll
                    for (int n = 0; n < 2; ++n) acc[a][b][m][n] = (f32x4){0.f, 0.f, 0.f, 0.f};
        }
        cur = nxt; cA = nA; cB = nB; ++ui;
        if constexpr (GA) {
#pragma unroll
            for (int h = 0; h < 2; ++h)
#pragma unroll
                for (int i = 0; i < 2; ++i) cv[h][i] = nv[h][i]; }
        if (wr == 1) PG8_BAR;
    }
    PG8_WAIT_V(0);
    PG8_BAR;
#undef PG8_SA
#undef PG8_SB
#undef PG8_STAGE2
#undef PG8_STAGEB
#undef PG8_STAGEA
#undef PG8_LDA
#undef PG8_LDB
#undef PG8_MMA
#undef PG8_WAIT_V
#undef PG8_WAIT_L
#undef PG8_BAR
#undef PG8_SCHED
}
__device__ __forceinline__ void dense_voff(int K, unsigned (&v)[2][2]) {
#pragma unroll
    for (int i = 0; i < 2; ++i) { int R, C; stage_rc((int)threadIdx.x * 16 + i * 8192, R, C);
        v[0][i] = (unsigned)(R * K + C) * 2u; v[1][i] = (unsigned)((R + HALF) * K + C) * 2u; }
}
}

struct ProbDense {
    static constexpr bool GATHER = false;
    const char* A; const char* Bt; int K, nM, nN, G, c;
    __device__ __forceinline__ bool next(int i, pg8::Unit& u) const { u.e = 0; return pg8::static_tile(i * G + c, nM, nN, u.pm, u.pn); }
    __device__ __forceinline__ const char* a_base(const pg8::Unit& u) const { return A + (size_t)u.pm * 256 * K * 2; }
    __device__ __forceinline__ const char* b_base(const pg8::Unit& u) const { return Bt + (size_t)u.pn * 256 * K * 2; }
};
struct ProbBranch {
    static constexpr bool GATHER = false;
    const char* A; const char* Bt; int K, G, c;
    __device__ __forceinline__ bool next(int i, pg8::Unit& u) const { u.e = i % 3; return pg8::static_tile((i / 3) * G + c, 64, 4, u.pm, u.pn); }
    __device__ __forceinline__ const char* a_base(const pg8::Unit& u) const { return A + ((size_t)u.e * TOK + (size_t)u.pm * 256) * 512 * 2; }
    __device__ __forceinline__ const char* b_base(const pg8::Unit& u) const { return Bt + ((size_t)u.e * DM + (size_t)u.pn * 256) * 512 * 2; }
};
template <int NPN, bool GATHER_> struct ProbGrouped {
    static constexpr bool GATHER = GATHER_;
    const char* A; const char* Bt; int K; int G, c; volatile LAS unsigned* MISC; const int* ltok; size_t b_estride; int tid;
    __device__ __forceinline__ bool next(int i, pg8::Unit& u) const {
        const int tot = (int)MISC[128 + 65];
        int tl;
        if (NPN == 4) {
            const int P = (c & 7) | ((c >> 4) << 3), half = (c >> 3) & 1;
            tl = (i >> 1) * (G >> 1) + P; u.pn = 2 * half + (i & 1);
            if (tl >= tot) return false;
        } else {
            const int L = i * G + c;
            if (L >= tot * NPN) return false;
            tl = L / NPN; u.pn = L % NPN;
        }
        int lo_ = 0, hi_ = 64;
#pragma unroll 1
        while (lo_ < hi_) { const int mid = (lo_ + hi_ + 1) >> 1; if ((int)MISC[128 + mid] <= tl) lo_ = mid; else hi_ = mid - 1; }
        u.e = lo_; u.pm = tl - (int)MISC[128 + lo_]; return true;
    }
    __device__ __forceinline__ const char* a_base(const pg8::Unit& u) const { return GATHER ? A : A + ((size_t)MISC[32 + u.e] + (size_t)u.pm * 256) * K * 2; }
    __device__ __forceinline__ const char* b_base(const pg8::Unit& u) const { return Bt + (size_t)u.e * b_estride + (size_t)u.pn * 256 * K * 2; }
    __device__ __forceinline__ void a_voff(const pg8::Unit& u, unsigned (&v)[2][2]) const {
        const int cnt = (int)MISC[256 + u.e];
        const int t_ = tid * 64 + lane_id();
#pragma unroll
        for (int i = 0; i < 2; ++i) { int R, C; pg8::stage_rc(t_ * 16 + i * 8192, R, C);
#pragma unroll
            for (int h = 0; h < 2; ++h) { const int ri = u.pm * 256 + h * 128 + R; const int rc = ri < cnt ? ri : (cnt > 0 ? cnt - 1 : 0);
                const int tok = (u.e < 64) ? ((const GAS int*)ltok)[(size_t)u.e * TOK + rc] : rc;
                v[h][i] = (unsigned)(tok * K + C) * 2u; } }
    }
};

__device__ __forceinline__ unsigned pk4u8(const f32x4& v) {
    unsigned w = __builtin_amdgcn_cvt_pk_u8_f32(v[0] * 255.0f, 0, 0u); w = __builtin_amdgcn_cvt_pk_u8_f32(v[1] * 255.0f, 1, w); w = __builtin_amdgcn_cvt_pk_u8_f32(v[2] * 255.0f, 2, w); return __builtin_amdgcn_cvt_pk_u8_f32(v[3] * 255.0f, 3, w); }
struct EpiProj {
    static constexpr int NST = 0;
    bf16_t* P; const float* c64; const float* s64; const float* c32; const float* s32; const float* ikg; const float* ikb; float* kpart;
    __device__ __forceinline__ void operator()(const f32x4 (&acc)[2][2][4][2], const pg8::Unit& u, int wr, int wc, int fr_, int fq_) const {
        int fr = fr_, fq = fq_; asm volatile("" : "+v"(fr), "+v"(fq));
        const int pn = u.pn;
        const bool kc = (pn == 10 || pn == 11);
        f32x4 ks1[2] = {{0.f, 0.f, 0.f, 0.f}, {0.f, 0.f, 0.f, 0.f}}, ks2[2] = {{0.f, 0.f, 0.f, 0.f}, {0.f, 0.f, 0.f, 0.f}};
        int mode;
        if (pn < 4) mode = 2; else if (pn < 6) mode = 1; else if (pn < 8) mode = 0; else if (pn < 10) mode = 2; else if (pn < 12) mode = 1; else if (pn < 14) mode = 0;
        else if (pn < 26) mode = 3; else if (pn == 26) mode = 4; else mode = (wc == 0) ? 1 : (wc == 2 ? 5 : 0);
        const int row0 = u.pm * 256 + wr * 64 + fr;
        const int tcb = (pn == 26) ? (pn * 256 + 32 * (2 * wc + (fq >> 1)) + 8 * (fq & 1)) : (pn * 256 + 64 * wc + 8 * fq);
        const int bjs = (pn == 26) ? 16 : 32;
#pragma unroll
        for (int ai = 0; ai < 2; ++ai)
#pragma unroll
            for (int m = 0; m < 4; ++m) {
                const int row = row0 + ai * 128 + m * 16, t = row & (SEQ - 1);
                f32x4 x1[2] = {acc[ai][0][m][0], acc[ai][0][m][1]}, x2[2] = {acc[ai][1][m][0], acc[ai][1][m][1]};
                if (mode == 1 || mode == 2) {
#pragma unroll
                    for (int n = 0; n < 2; ++n) { const f32x4 cs = *(const GAS f32x4*)(c64 + t * 32 + 8 * fq + 4 * n), sn = *(const GAS f32x4*)(s64 + t * 32 + 8 * fq + 4 * n);
                        const f32x4 a = x1[n] * cs - x2[n] * sn, b = x2[n] * cs + x1[n] * sn; x1[n] = a; x2[n] = b;
                        if (mode == 2) { x1[n] *= QSCALE; x2[n] *= QSCALE; } }
                    if (kc) { ks1[0] += x1[0]; ks1[1] += x1[1]; ks2[0] += x2[0]; ks2[1] += x2[1]; }
                } else if (mode == 3) {
#pragma unroll
                    for (int n = 0; n < 2; ++n)
#pragma unroll
                        for (int e = 0; e < 4; ++e) { x1[n][e] = sigmoidf_(x1[n][e]); x2[n][e] = sigmoidf_(x2[n][e]); }
                } else if (mode == 4) {
#pragma unroll
                    for (int n = 0; n < 2; ++n) { const f32x4 cs = *(const GAS f32x4*)(c32 + t * 16 + 8 * (fq & 1) + 4 * n), sn = *(const GAS f32x4*)(s32 + t * 16 + 8 * (fq & 1) + 4 * n);
                        const f32x4 a = x1[n] * cs - x2[n] * sn, b = x2[n] * cs + x1[n] * sn; x1[n] = a; x2[n] = b; }
                } else if (mode == 5) {
                    float s = (x1[0][0] + x1[0][1]) + (x1[0][2] + x1[0][3]) + (x1[1][0] + x1[1][1]) + (x1[1][2] + x1[1][3]);
                    s += __shfl_xor(s, 16); s += __shfl_xor(s, 32);
                    const float mean = s * (1.f / 32.f); float q = 0.f;
#pragma unroll
                    for (int n = 0; n < 2; ++n) { x1[n] = x1[n] - mean; q += (x1[n][0] * x1[n][0] + x1[n][1] * x1[n][1]) + (x1[n][2] * x1[n][2] + x1[n][3] * x1[n][3]); }
                    q += __shfl_xor(q, 16); q += __shfl_xor(q, 32);
                    const float rstd = 1.f / sqrtf(q * (1.f / 32.f) + LN_EPS);
#pragma unroll
                    for (int n = 0; n < 2; ++n) { const f32x4 g = *(const GAS f32x4*)(ikg + 8 * fq + 4 * n), bb = *(const GAS f32x4*)(ikb + 8 * fq + 4 * n);
                        const f32x4 v = x1[n] * rstd * g + bb;
                        f32x4 o; o[0] = __shfl_xor(v[0], 32); o[1] = __shfl_xor(v[1], 32); o[2] = __shfl_xor(v[2], 32); o[3] = __shfl_xor(v[3], 32);
                        const f32x4 cs = *(const GAS f32x4*)(c32 + t * 16 + 8 * (fq & 1) + 4 * n), sn = *(const GAS f32x4*)(s32 + t * 16 + 8 * (fq & 1) + 4 * n);
                        x1[n] = (fq < 2) ? (v * cs - o * sn) : (v * cs + o * sn); }
                }
                if (mode == 3) {
                    unsigned char* gp = (unsigned char*)P + (size_t)row * (NPROJ * 2) + 2 * (C_GA + 1024 * ((pn - 14) >> 2)) + 256 * ((pn - 14) & 3) + 64 * wc + 8 * fq;
                    u32x2 g0, g1;
                    g0.x = pk4u8(x1[0]); g0.y = pk4u8(x1[1]); g1.x = pk4u8(x2[0]); g1.y = pk4u8(x2[1]);
                    *(GAS u32x2*)gp = g0; *(GAS u32x2*)(gp + 32) = g1;
                    if (m == 3) asm volatile("" ::: "memory");
                    continue;
                }
                bf16_t* rp = P + (size_t)row * NPROJ + tcb;
                u32x4 w0; w0.x = cvtpk(x1[0][0], x1[0][1]); w0.y = cvtpk(x1[0][2], x1[0][3]); w0.z = cvtpk(x1[1][0], x1[1][1]); w0.w = cvtpk(x1[1][2], x1[1][3]);
                u32x4 w1; w1.x = cvtpk(x2[0][0], x2[0][1]); w1.y = cvtpk(x2[0][2], x2[0][3]); w1.z = cvtpk(x2[1][0], x2[1][1]); w1.w = cvtpk(x2[1][2], x2[1][3]);
                *(GAS u32x4*)rp = w0; *(GAS u32x4*)(rp + bjs) = w1;
                if (m == 3) asm volatile("" ::: "memory");
            }
        if (kc) {
#pragma unroll
            for (int n = 0; n < 2; ++n)
#pragma unroll
                for (int e = 0; e < 4; ++e) {
#pragma unroll
                    for (int sh = 1; sh < 16; sh <<= 1) { ks1[n][e] += __shfl_xor(ks1[n][e], sh); ks2[n][e] += __shfl_xor(ks2[n][e], sh); } }
            if (fr == 0) { const int b = u.pm >> 3, nb = u.pm & 7, h = 4 * (pn - 10) + wc;
                float* kp = kpart + (size_t)wr * 32768 + ((size_t)(b * 8 + h) * 8 + nb) * 64 + 8 * fq;
                *(GAS f32x4*)kp = ks1[0]; *(GAS f32x4*)(kp + 4) = ks1[1]; *(GAS f32x4*)(kp + 32) = ks2[0]; *(GAS f32x4*)(kp + 36) = ks2[1]; }
        }
    }
};
#define UB0(X) ((float)((X) & 0xffu))
#define UB1(X) ((float)(((X) >> 8) & 0xffu))
#define UB2(X) ((float)(((X) >> 16) & 0xffu))
#define UB3(X) ((float)((X) >> 24))
struct EpiBranch {
    static constexpr int NST = 0;
    static constexpr bool CHAIN = true;
    const bf16_t* P; bf16_t* Mg;
    __device__ __forceinline__ void operator()(f32x4 (&acc)[2][2][4][2], const pg8::Unit& u, int wr, int wc, int fr_, int fq_) const {
        int fr = fr_, fq = fq_; asm volatile("" : "+v"(fr), "+v"(fq));
        const int br = u.e; const int gcol = (br == 0 ? C_GA : (br == 1 ? C_GB : C_GC));
        const int row0 = u.pm * 256 + wr * 64 + fr, col0 = u.pn * 256 + wc * 32 + 8 * fq;
#define GCL(x) __builtin_fmaxf((x), 0.25f)
#pragma unroll
        for (int aq = 0; aq < 4; ++aq) { const int ai = aq >> 1, mb = (aq & 1) * 2;
            u32x2 gw[4], hw[4];
#pragma unroll
            for (int g = 0; g < 4; ++g) { const int row = row0 + ai * 128 + (mb + (g >> 1)) * 16, col = col0 + (g & 1) * 128;
                const unsigned char* gp = (const unsigned char*)P + (size_t)row * (NPROJ * 2) + 2 * gcol + col;
                gw[g] = *(const GAS u32x2*)gp; hw[g] = gw[g];
                if (br < 2) hw[g] = *(const GAS u32x2*)(gp + 2 * 1024); }
            if (br < 2) {
#pragma unroll
                for (int g = 0; g < 4; ++g) { const int m = mb + (g >> 1), bj = g & 1;
                    f32x4& v0 = acc[ai][bj][m][0]; f32x4& v1 = acc[ai][bj][m][1];
                    v0[0] *= GCL(UB0(gw[g].x)) * __builtin_amdgcn_rcpf(GCL(UB0(hw[g].x))); v0[1] *= GCL(UB1(gw[g].x)) * __builtin_amdgcn_rcpf(GCL(UB1(hw[g].x)));
                    v0[2] *= GCL(UB2(gw[g].x)) * __builtin_amdgcn_rcpf(GCL(UB2(hw[g].x))); v0[3] *= GCL(UB3(gw[g].x)) * __builtin_amdgcn_rcpf(GCL(UB3(hw[g].x)));
                    v1[0] *= GCL(UB0(gw[g].y)) * __builtin_amdgcn_rcpf(GCL(UB0(hw[g].y))); v1[1] *= GCL(UB1(gw[g].y)) * __builtin_amdgcn_rcpf(GCL(UB1(hw[g].y)));
                    v1[2] *= GCL(UB2(gw[g].y)) * __builtin_amdgcn_rcpf(GCL(UB2(hw[g].y))); v1[3] *= GCL(UB3(gw[g].y)) * __builtin_amdgcn_rcpf(GCL(UB3(hw[g].y))); }
            } else {
#pragma unroll
                for (int g = 0; g < 4; ++g) { const int m = mb + (g >> 1), bj = g & 1; const int row = row0 + ai * 128 + m * 16, col = col0 + bj * 128;
                    f32x4 v0 = acc[ai][bj][m][0] * (1.0f / 255.0f), v1 = acc[ai][bj][m][1] * (1.0f / 255.0f);
                    v0[0] *= GCL(UB0(gw[g].x)); v0[1] *= GCL(UB1(gw[g].x)); v0[2] *= GCL(UB2(gw[g].x)); v0[3] *= GCL(UB3(gw[g].x));
                    v1[0] *= GCL(UB0(gw[g].y)); v1[1] *= GCL(UB1(gw[g].y)); v1[2] *= GCL(UB2(gw[g].y)); v1[3] *= GCL(UB3(gw[g].y));
                    u32x4 w; w.x = cvtpk(v0[0], v0[1]); w.y = cvtpk(v0[2], v0[3]); w.z = cvtpk(v1[0], v1[1]); w.w = cvtpk(v1[2], v1[3]);
                    *(GAS u32x4*)(Mg + (size_t)row * DM + col) = w; }
            }
            asm volatile("" ::: "memory");
        }
#undef GCL
    }
};
struct EpiY {
    static constexpr int NST = 0;
    bf16_t* O;
    __device__ __forceinline__ void operator()(const f32x4 (&acc)[2][2][4][2], const pg8::Unit& u, int wr, int wc, int fr_, int fq_) const {
        int fr = fr_, fq = fq_; asm volatile("" : "+v"(fr), "+v"(fq));
        const int row0 = u.pm * 256 + wr * 64 + fr, col0 = (u.pn & 1) * 256 + wc * 32 + 8 * fq;
        bf16_t* base = O + (size_t)(u.pn >> 1) * TOK * 512;
#pragma unroll
        for (int ai = 0; ai < 2; ++ai)
#pragma unroll
            for (int m = 0; m < 4; ++m) { bf16_t* rp = base + (size_t)(row0 + ai * 128 + m * 16) * 512 + col0;
#pragma unroll
                for (int bj = 0; bj < 2; ++bj) { const f32x4 v0 = acc[ai][bj][m][0], v1 = acc[ai][bj][m][1];
                    u32x4 w; w.x = cvtpk(v0[0], v0[1]); w.y = cvtpk(v0[2], v0[3]); w.z = cvtpk(v1[0], v1[1]); w.w = cvtpk(v1[2], v1[3]);
                    *(GAS u32x4*)(rp + bj * 128) = w; } }
    }
};
struct EpiBf16 {
    static constexpr int NST = 0;
    bf16_t* O; int ldc;
    __device__ __forceinline__ void operator()(const f32x4 (&acc)[2][2][4][2], const pg8::Unit& u, int wr, int wc, int fr_, int fq_) const {
        int fr = fr_, fq = fq_; asm volatile("" : "+v"(fr), "+v"(fq));
        const int row0 = u.pm * 256 + wr * 64 + fr, col0 = u.pn * 256 + wc * 32 + 8 * fq;
#pragma unroll
        for (int ai = 0; ai < 2; ++ai)
#pragma unroll
            for (int m = 0; m < 4; ++m) { bf16_t* rp = O + (size_t)(row0 + ai * 128 + m * 16) * ldc + col0;
#pragma unroll
                for (int bj = 0; bj < 2; ++bj) { const f32x4 v0 = acc[ai][bj][m][0], v1 = acc[ai][bj][m][1];
                    u32x4 w; w.x = cvtpk(v0[0], v0[1]); w.y = cvtpk(v0[2], v0[3]); w.z = cvtpk(v1[0], v1[1]); w.w = cvtpk(v1[2], v1[3]);
                    *(GAS u32x4*)(rp + bj * 128) = w; } }
    }
};
struct EpiGateUp {
    static constexpr int NST = 0;
    bf16_t* H; const float* lw; volatile LAS unsigned* MISC;
    __device__ __forceinline__ void operator()(const f32x4 (&acc)[2][2][4][2], const pg8::Unit& u, int wr, int wc, int fr_, int fq_) const {
        int fr = fr_, fq = fq_; asm volatile("" : "+v"(fr), "+v"(fq));
        const int e = u.e, cnt = (int)MISC[256 + e]; const size_t slot0 = (size_t)MISC[32 + e];
        const int r0 = u.pm * 256 + wr * 64 + fr, f0 = u.pn * 128 + wc * 32 + 8 * fq;
        float wts[8];
#pragma unroll
        for (int g = 0; g < 8; ++g) { const int ri = r0 + (g >> 2) * 128 + (g & 3) * 16; const int rc = ri < cnt ? ri : (cnt > 0 ? cnt - 1 : 0);
            wts[g] = (e < 64) ? ((const GAS float*)lw)[(size_t)e * TOK + rc] : 1.0f; }
#pragma unroll
        for (int ai = 0; ai < 2; ++ai)
#pragma unroll
            for (int m = 0; m < 4; ++m) { const int ri = r0 + ai * 128 + m * 16;
                if (ri < cnt) {
                    const float wt = wts[ai * 4 + m];
                    const f32x4 g0 = acc[ai][0][m][0], g1 = acc[ai][0][m][1], u0 = acc[ai][1][m][0], u1 = acc[ai][1][m][1];
                    float h[8];
#pragma unroll
                    for (int j = 0; j < 4; ++j) { h[j] = g0[j] * sigmoidf_(g0[j]) * u0[j] * wt; h[4 + j] = g1[j] * sigmoidf_(g1[j]) * u1[j] * wt; }
                    u32x4 w; w.x = cvtpk(h[0], h[1]); w.y = cvtpk(h[2], h[3]); w.z = cvtpk(h[4], h[5]); w.w = cvtpk(h[6], h[7]);
                    *(GAS u32x4*)(H + (slot0 + ri) * EDIM + f0) = w; } }
    }
};
struct EpiDown {
    static constexpr int NST = 0;
    unsigned char* Y8; bf16_t* YS; volatile LAS unsigned* MISC; unsigned char* dump;
    __device__ __forceinline__ void operator()(const f32x4 (&acc)[2][2][4][2], const pg8::Unit& u, int wr, int wc, int fr_, int fq_) const {
        int fr = fr_, fq = fq_; asm volatile("" : "+v"(fr), "+v"(fq));
        const int e = u.e, cnt = (int)MISC[256 + e]; const size_t slot0 = (size_t)MISC[32 + e];
        const int r0 = u.pm * 256 + wr * 64 + fr, colb = u.pn * 256 + wc * 64 + 16 * fq;
        unsigned char* dmp = dump + (size_t)(fr * 4 + fq) * 32;
#pragma unroll
        for (int ai = 0; ai < 2; ++ai)
#pragma unroll
            for (int m = 0; m < 4; ++m) { const int ri = r0 + ai * 128 + m * 16; const bool ok = ri < cnt;
                const f32x4 a0 = acc[ai][0][m][0], a1 = acc[ai][0][m][1], b0 = acc[ai][1][m][0], b1 = acc[ai][1][m][1];
                if (e < 64) {
                    float v[16] = {a0[0], a0[1], a0[2], a0[3], a1[0], a1[1], a1[2], a1[3], b0[0], b0[1], b0[2], b0[3], b1[0], b1[1], b1[2], b1[3]};
#pragma unroll
                    for (int i = 0; i < 16; ++i) v[i] = __builtin_amdgcn_fmed3f(v[i] * Y8_SCALE, -440.f, 440.f);
                    u32x4 w;
                    { int p = __builtin_amdgcn_cvt_pk_fp8_f32(v[0], v[1], 0, false); p = __builtin_amdgcn_cvt_pk_fp8_f32(v[2], v[3], p, true); w.x = (unsigned)p; }
                    { int p = __builtin_amdgcn_cvt_pk_fp8_f32(v[4], v[5], 0, false); p = __builtin_amdgcn_cvt_pk_fp8_f32(v[6], v[7], p, true); w.y = (unsigned)p; }
                    { int p = __builtin_amdgcn_cvt_pk_fp8_f32(v[8], v[9], 0, false); p = __builtin_amdgcn_cvt_pk_fp8_f32(v[10], v[11], p, true); w.z = (unsigned)p; }
                    { int p = __builtin_amdgcn_cvt_pk_fp8_f32(v[12], v[13], 0, false); p = __builtin_amdgcn_cvt_pk_fp8_f32(v[14], v[15], p, true); w.w = (unsigned)p; }
                    unsigned char* dst = ok ? (Y8 + (slot0 + (size_t)ri) * DM + colb) : dmp;
                    *(GAS u32x4*)dst = w;
                } else {
                    u32x4 w0, w1;
                    w0.x = cvtpk(a0[0], a0[1]); w0.y = cvtpk(a0[2], a0[3]); w0.z = cvtpk(a1[0], a1[1]); w0.w = cvtpk(a1[2], a1[3]);
                    w1.x = cvtpk(b0[0], b0[1]); w1.y = cvtpk(b0[2], b0[3]); w1.z = cvtpk(b1[0], b1[1]); w1.w = cvtpk(b1[2], b1[3]);
                    bf16_t* dst = ok ? (YS + (size_t)ri * DM + colb) : (bf16_t*)dmp;
                    *(GAS u32x4*)dst = w0; *(GAS u32x4*)(dst + 8) = w1;
                } }
    }
};

__device__ __forceinline__ void ph_kmean(Frame& F) {
    const bf16_t* P = (const bf16_t*)(F.ws + WS_PROJ); float* km = (float*)(F.ws + WS_KMEAN);
    LAS float* red = (LAS float*)F.lds;
    for (int item = F.bid; item < 256; item += F.G) {
        const int b = item >> 5, n = (item >> 2) & 7, cq = item & 3;
        const int col = F.tid & 127, rq = F.tid >> 7;
        const GAS bf16_t* p = (const GAS bf16_t*)P + (size_t)(b * SEQ + n * 256 + rq * 64) * NPROJ + C_KC + cq * 128 + col;
        float s = 0.f;
#pragma unroll 8
        for (int r = 0; r < 64; ++r) s += bf2f(p[(size_t)r * NPROJ]);
        red[rq * 128 + col] = s;
        __syncthreads();
        if (F.tid < 128) { const float tot = ((red[col] + red[128 + col]) + red[256 + col]) + red[384 + col]; const int cc = cq * 128 + col, h = cc >> 6, d = cc & 63;
            km[((size_t)(b * 8 + h) * 8 + n) * 64 + d] = tot * (1.0f / 256.0f); }
        __syncthreads();
    }
}
__device__ __forceinline__ int crow(int r, int hi) { return (r & 3) + 8 * (r >> 2) + 4 * hi; }
__device__ __forceinline__ s16x4 vtr(const LAS unsigned char* p) { return __builtin_bit_cast(s16x4, __builtin_amdgcn_ds_read_tr16_b64_v4i16((LAS s16x4*)p)); }

constexpr float FNEG = -1e30f, FTHR = 8.0f;
struct FlashState { f32x16 o0, o1, cN, cF; float mref, lrun; bool started; int cur_nb; unsigned pat; };
#ifndef V1EARLY
#define V1EARLY 1
#endif
template <int MODE>
__device__ __forceinline__ void flash_step(FlashState& st, const bf16x8 (&qf)[4], const LAS unsigned char* kvb, int kt, int qt, int tq, int q, int hi, int krd, int ksw, int vrd,
                                           const LAS unsigned* maskw, unsigned selbits, int own) {
    const int key0 = 64 * kt;
    bool active = (key0 <= 32 * qt + 31);
    if (MODE == 2) { const int nb = kt >> 2; if (nb != own && __ballot((selbits >> nb) & 1u) == 0ull) active = false; }
    if (!active) return;
    const bool diag = (key0 + 63 > 32 * qt);
    int cls = 0;
    if (MODE == 1) { const int dmin = 32 * qt - key0 - 63, dmax = 32 * qt + 31 - key0; cls = (dmin > 512) ? 1 : ((dmin > 128 && dmax <= 512) ? 2 : 3);
        if (cls != st.cur_nb) { st.cur_nb = cls;
            const float v16 = (cls == 2) ? 1.0f : 0.f, v4 = (cls == 1) ? FNEG : 0.f, v0 = (cls == 3) ? 0.f : FNEG;
#pragma unroll
            for (int r = 0; r < 16; ++r) { const bool c16 = (st.pat >> r) & 1u, c4 = (st.pat >> (16 + r)) & 1u; st.cN[r] = (c16 ? v16 : (c4 ? v4 : v0)) - st.mref; } }
        cls = 0; }
    if (MODE == 2) { const int nb = kt >> 2;
        if (nb != st.cur_nb) { st.cur_nb = nb; const bool sel = (nb == own) || (((selbits >> nb) & 1u) != 0u);
#pragma unroll
            for (int r = 0; r < 16; ++r) st.cF[r] = sel ? st.cN[r] : FNEG; }
        cls = 1; }
    f32x16 p0, p1;
    bf16x8 kf0[4], kf1[4];
#pragma unroll
    for (int s = 0; s < ((MODE == 1 && !V1EARLY) ? 2 : 4); ++s) { kf0[s] = *(const LAS bf16x8*)(kvb + krd + (((2 * s + hi) ^ ksw) * 16)); kf1[s] = *(const LAS bf16x8*)(kvb + 4096 + krd + (((2 * s + hi) ^ ksw) * 16)); }
    __builtin_amdgcn_sched_barrier(0);
    { if (cls == 1) { p0 = __builtin_amdgcn_mfma_f32_32x32x16_bf16(kf0[0], qf[0], st.cF, 0, 0, 0); p1 = __builtin_amdgcn_mfma_f32_32x32x16_bf16(kf1[0], qf[0], st.cF, 0, 0, 0); }
      else { p0 = __builtin_amdgcn_mfma_f32_32x32x16_bf16(kf0[0], qf[0], st.cN, 0, 0, 0); p1 = __builtin_amdgcn_mfma_f32_32x32x16_bf16(kf1[0], qf[0], st.cN, 0, 0, 0); } }
    if (MODE == 1 && !V1EARLY) {
        p0 = __builtin_amdgcn_mfma_f32_32x32x16_bf16(kf0[1], qf[1], p0, 0, 0, 0); p1 = __builtin_amdgcn_mfma_f32_32x32x16_bf16(kf1[1], qf[1], p1, 0, 0, 0);
#pragma unroll
        for (int s = 2; s < 4; ++s) { kf0[s - 2] = *(const LAS bf16x8*)(kvb + krd + (((2 * s + hi) ^ ksw) * 16)); kf1[s - 2] = *(const LAS bf16x8*)(kvb + 4096 + krd + (((2 * s + hi) ^ ksw) * 16)); }
#pragma unroll
        for (int s = 2; s < 4; ++s) { p0 = __builtin_amdgcn_mfma_f32_32x32x16_bf16(kf0[s - 2], qf[s], p0, 0, 0, 0); p1 = __builtin_amdgcn_mfma_f32_32x32x16_bf16(kf1[s - 2], qf[s], p1, 0, 0, 0); }
    } else {
#pragma unroll
        for (int s = 1; s < 4; ++s) { p0 = __builtin_amdgcn_mfma_f32_32x32x16_bf16(kf0[s], qf[s], p0, 0, 0, 0); p1 = __builtin_amdgcn_mfma_f32_32x32x16_bf16(kf1[s], qf[s], p1, 0, 0, 0); }
    }
    const LAS unsigned char* vb = kvb + vrd;
    s16x4 va0[4], va1[4], vc0[4], vc1[4];
    if (MODE != 1 || V1EARLY) {
#pragma unroll
        for (int ks = 0; ks < 4; ++ks) { va0[ks] = vtr(vb + ks * 1024); va1[ks] = vtr(vb + ks * 1024 + 512); vc0[ks] = vtr(vb + 4096 + ks * 1024); vc1[ks] = vtr(vb + 4096 + ks * 1024 + 512); }
        __builtin_amdgcn_sched_barrier(0);
    }
    if (MODE == 1 && st.cur_nb == 3) {
        const int dmin = 32 * qt - key0 - 63;
        const int db = tq - key0;
        const bool s512 = dmin > 128;
        const int thr = s512 ? 512 : 128;
        const float a16 = s512 ? 1.0f : 1.5849625007f, a4 = s512 ? 0.f : 1.0f, a0 = s512 ? FNEG : 0.f;
        const float b16 = s512 ? 0.f : 1.0f, b4 = s512 ? FNEG : 0.f;
#pragma unroll
        for (int r = 0; r < 16; ++r) { const bool c16 = (st.pat >> r) & 1u, c4 = (st.pat >> (16 + r)) & 1u;
            const float lo = c16 ? a16 : (c4 ? a4 : a0), hi_ = c16 ? b16 : (c4 ? b4 : FNEG);
            const int d0 = db - crow(r, hi), d1 = d0 - 32;
            p0[r] += (d0 < 0) ? FNEG : ((d0 <= thr) ? lo : hi_); p1[r] += (d1 < 0) ? FNEG : ((d1 <= thr) ? lo : hi_); }
    } else if (MODE != 1 && diag) {
#pragma unroll
        for (int r = 0; r < 16; ++r) { const int kk = key0 + crow(r, hi); p0[r] = (kk <= tq) ? p0[r] : FNEG; p1[r] = (kk + 32 <= tq) ? p1[r] : FNEG; }
    }
    float mx;
    { float a = __builtin_fmaxf(__builtin_fmaxf(p0[0], p0[1]), p1[0]), c = __builtin_fmaxf(__builtin_fmaxf(p0[2], p0[3]), p1[1]);
      a = __builtin_fmaxf(__builtin_fmaxf(a, p1[2]), p1[3]);
#pragma unroll
      for (int r = 4; r < 16; r += 4) { a = __builtin_fmaxf(__builtin_fmaxf(a, p0[r]), p0[r + 1]); c = __builtin_fmaxf(__builtin_fmaxf(c, p0[r + 2]), p0[r + 3]);
          a = __builtin_fmaxf(__builtin_fmaxf(a, p1[r]), p1[r + 1]); c = __builtin_fmaxf(__builtin_fmaxf(c, p1[r + 2]), p1[r + 3]); }
      mx = __builtin_fmaxf(a, c);
      { auto rr = __builtin_amdgcn_permlane32_swap(__float_as_uint(mx), __float_as_uint(mx), false, false); mx = __builtin_fmaxf(__uint_as_float(rr[0]), __uint_as_float(rr[1])); } }
    const bool resc = (mx > FTHR) || (!st.started && mx > -1e29f);
    if (__any(resc)) {
        const float dl = resc ? mx : 0.f;
        st.started = st.started || resc;
        st.mref += dl;
        const float f = __builtin_amdgcn_exp2f(-dl);
        st.lrun *= f;
#pragma unroll
        for (int r = 0; r < 16; ++r) { p0[r] -= dl; p1[r] -= dl; st.o0[r] *= f; st.o1[r] *= f; if (MODE == 1) st.cN[r] -= dl; else st.cN[r] = -st.mref; }
        if (MODE == 2) st.cur_nb = -1;
    }
    float ls = 0.f;
    if (MODE == 0) {
        const unsigned w0 = maskw[q * 65 + 2 * kt], w1 = maskw[q * 65 + 2 * kt + 1];
#pragma unroll
        for (int r = 0; r < 16; ++r) { const int kk = crow(r, hi);
            const float e0 = __uint_as_float(__float_as_uint(__builtin_amdgcn_exp2f(p0[r])) & (unsigned)__builtin_amdgcn_sbfe((int)w0, kk, 1));
            const float e1 = __uint_as_float(__float_as_uint(__builtin_amdgcn_exp2f(p1[r])) & (unsigned)__builtin_amdgcn_sbfe((int)w1, kk, 1));
            p0[r] = e0; p1[r] = e1; ls += e0 + e1; }
    } else {
#pragma unroll
        for (int r = 0; r < 16; ++r) { const float e0 = __builtin_amdgcn_exp2f(p0[r]), e1 = __builtin_amdgcn_exp2f(p1[r]); p0[r] = e0; p1[r] = e1; ls += e0 + e1; }
    }
    st.lrun += ls;
    bf16x8 pb[4];
    { u32x4 w;
      w.x = cvtpk(p0[0], p0[1]); w.y = cvtpk(p0[2], p0[3]); w.z = cvtpk(p0[4], p0[5]); w.w = cvtpk(p0[6], p0[7]); pb[0] = __builtin_bit_cast(bf16x8, w);
      w.x = cvtpk(p0[8], p0[9]); w.y = cvtpk(p0[10], p0[11]); w.z = cvtpk(p0[12], p0[13]); w.w = cvtpk(p0[14], p0[15]); pb[1] = __builtin_bit_cast(bf16x8, w);
      w.x = cvtpk(p1[0], p1[1]); w.y = cvtpk(p1[2], p1[3]); w.z = cvtpk(p1[4], p1[5]); w.w = cvtpk(p1[6], p1[7]); pb[2] = __builtin_bit_cast(bf16x8, w);
      w.x = cvtpk(p1[8], p1[9]); w.y = cvtpk(p1[10], p1[11]); w.z = cvtpk(p1[12], p1[13]); w.w = cvtpk(p1[14], p1[15]); pb[3] = __builtin_bit_cast(bf16x8, w); }
    if (MODE == 1 && !V1EARLY) {
#pragma unroll
        for (int ks = 0; ks < 4; ++ks) { va0[ks] = vtr(vb + ks * 1024); va1[ks] = vtr(vb + ks * 1024 + 512); vc0[ks] = vtr(vb + 4096 + ks * 1024); vc1[ks] = vtr(vb + 4096 + ks * 1024 + 512); }
    }
#pragma unroll
    for (int ks = 0; ks < 4; ++ks) {
        const s16x4 a0 = va0[ks], a1 = va1[ks], c0 = vc0[ks], c1 = vc1[ks];
        const bf16x8 va = {a0[0], a0[1], a0[2], a0[3], a1[0], a1[1], a1[2], a1[3]}, vc = {c0[0], c0[1], c0[2], c0[3], c1[0], c1[1], c1[2], c1[3]};
        st.o0 = __builtin_amdgcn_mfma_f32_32x32x16_bf16(va, pb[ks], st.o0, 0, 0, 0);
        st.o1 = __builtin_amdgcn_mfma_f32_32x32x16_bf16(vc, pb[ks], st.o1, 0, 0, 0);
    }
}
__device__ __forceinline__ void glds16_asm(const GAS void* g, unsigned lds_base) {
    unsigned sv; asm volatile("s_mov_b32 %0, m0\n\ts_mov_b32 m0, %2\n\ts_nop 0\n\tglobal_load_lds_dwordx4 %1, off\n\ts_mov_b32 m0, %0" : "=&s"(sv) : "v"(g), "s"(lds_base) : "memory"); }
template <int MODE>
__device__ __forceinline__ void flash_block(const bf16_t* P, int b, int nkt, int qt, int qcol, int kcol, int vcol, bf16_t* Oout  ,
                                            LAS unsigned char* kv  , const LAS unsigned* maskw  , unsigned selbits  , int tid_) {
    int tid = tid_; asm volatile("" : "+v"(tid));
    const int lane = tid & 63, q = lane & 31, hi = lane >> 5;
    const int tq = 32 * qt + q;
    const GAS bf16_t* Pb = (const GAS bf16_t*)P + (size_t)b * SEQ * NPROJ;
    bf16x8 qf[4];
#pragma unroll
    for (int s = 0; s < 4; ++s) qf[s] = *(const GAS bf16x8*)(Pb + (size_t)tq * NPROJ + qcol + 16 * s + 8 * hi);
    FlashState st; st.mref = 0.f; st.lrun = 0.f; st.started = false; st.cur_nb = -1;
#pragma unroll
    for (int r = 0; r < 16; ++r) { st.o0[r] = 0.f; st.o1[r] = 0.f; st.cN[r] = 0.f; st.cF[r] = 0.f; }
    st.pat = 0u;
    if (MODE == 1) {
#pragma unroll
        for (int r = 0; r < 16; ++r) { const int dm = (tq - crow(r, hi)) & 15; st.pat |= ((dm == 0) ? (1u << r) : 0u) | (((dm & 3) == 0) ? (1u << (16 + r)) : 0u); }
    }
    const int own = qt >> 3;
    const int wv = __builtin_amdgcn_readfirstlane(tid >> 6);
    const int krow = 8 * wv + (lane >> 3), kch = (lane & 7) ^ ((krow >> 1) & 7);
    const int vrow = 16 * (wv & 3) + (lane >> 2), vch = 4 * (wv >> 2) + (lane & 3);
    const GAS bf16_t* kg = Pb + (size_t)krow * NPROJ + kcol + 8 * kch;
    const GAS bf16_t* vg = Pb + (size_t)vrow * NPROJ + vcol + 8 * vch;
    const int krd = q * 128, ksw = (q >> 1) & 7;
    const int vrd = 8192 + ((lane >> 4) & 1) * 32 + (lane & 3) * 8 + (4 * hi + ((lane & 15) >> 2)) * 64;
    const size_t tstride = (size_t)64 * NPROJ;
    LAS unsigned char* kvw = kv + 1024 * wv;
    const unsigned kvw_a = (unsigned)__builtin_amdgcn_readfirstlane((int)(unsigned)(unsigned long long)kvw);
#define FB_STAGE(t, bufoff) do { glds16_asm(kg + (size_t)(t) * tstride, kvw_a + (unsigned)(bufoff)); glds16_asm(vg + (size_t)(t) * tstride, kvw_a + (unsigned)(bufoff) + 8192u); } while (0)
    const int ntm1 = nkt - 1;
    { const int t1 = 1 < ntm1 ? 1 : ntm1; FB_STAGE(0, 0); FB_STAGE(t1, 16384); }
    asm volatile("s_waitcnt vmcnt(0)" : "+v"(qf[0]), "+v"(qf[1]), "+v"(qf[2]), "+v"(qf[3]) :: "memory");
    __syncthreads();
    for (int kt = 0; kt < nkt; kt += 2) {
        const int sb = (kt & 2) * 16384;
        { const int t2 = kt + 2 < ntm1 ? kt + 2 : ntm1, t3 = kt + 3 < ntm1 ? kt + 3 : ntm1, ob = sb ^ 32768;
          FB_STAGE(t2, ob); FB_STAGE(t3, ob + 16384); }
        flash_step<MODE>(st, qf, kv + sb, kt, qt, tq, q, hi, krd, ksw, vrd, maskw, selbits, own);
        if (kt + 1 < nkt) flash_step<MODE>(st, qf, kv + sb + 16384, kt + 1, qt, tq, q, hi, krd, ksw, vrd, maskw, selbits, own);
        asm volatile("s_waitcnt vmcnt(0)" ::: "memory");
        __syncthreads();
    }
#undef FB_STAGE
    st.lrun += __shfl_xor(st.lrun, 32);
    const float rl = 1.0f / st.lrun;
    bf16_t* orow = Oout + (size_t)(b * SEQ + tq) * 512;
#pragma unroll
    for (int g = 0; g < 4; ++g) {
        u32x2 w; w.x = cvtpk(st.o0[4 * g] * rl, st.o0[4 * g + 1] * rl); w.y = cvtpk(st.o0[4 * g + 2] * rl, st.o0[4 * g + 3] * rl);
        *(GAS u32x2*)(orow + 8 * g + 4 * hi) = w;
        u32x2 x; x.x = cvtpk(st.o1[4 * g] * rl, st.o1[4 * g + 1] * rl); x.y = cvtpk(st.o1[4 * g + 2] * rl, st.o1[4 * g + 3] * rl);
        *(GAS u32x2*)(orow + 32 + 8 * g + 4 * hi) = x;
    }
}

constexpr int A_QI_OFF = 0, A_MASK_OFF = 16896, A_RED_OFF = 25216, A_FLAG_OFF = 27264, A_V_OFF = 32768;
__device__ __forceinline__ int wave_sum_dpp(int x) {
    x += __builtin_amdgcn_update_dpp(0, x, 0xB1, 0xF, 0xF, true);
    x += __builtin_amdgcn_update_dpp(0, x, 0x4E, 0xF, 0xF, true);
    x += __builtin_amdgcn_update_dpp(0, x, 0x141, 0xF, 0xF, true);
    x += __builtin_amdgcn_update_dpp(0, x, 0x140, 0xF, 0xF, true);
    return (__builtin_amdgcn_readlane(x, 0) + __builtin_amdgcn_readlane(x, 16)) + (__builtin_amdgcn_readlane(x, 32) + __builtin_amdgcn_readlane(x, 48));
}
__device__ __forceinline__ void dsa_unit(Frame& F, int b, int qt) {
    const bf16_t* P = (const bf16_t*)(F.ws + WS_PROJ);
    const GAS bf16_t* Pb = (const GAS bf16_t*)P + (size_t)b * SEQ * NPROJ;
    int w_ = F.wave; asm volatile("" : "+s"(w_)); int tid_ = w_ * 64 + lane_id();
    const int tid = tid_, lane = tid_ & 63, w = w_, q = lane & 31, hi = lane >> 5, tq = 32 * qt + q;
    LAS unsigned char* qis = F.lds + A_QI_OFF;
    LAS unsigned* maskw = (LAS unsigned*)(F.lds + A_MASK_OFF);
    LAS int* red = (LAS int*)(F.lds + A_RED_OFF);
    volatile LAS unsigned* flag = (volatile LAS unsigned*)(F.lds + A_FLAG_OFF);
    for (int id = tid; id < 1024; id += NTHREADS) { const int r = id >> 5, c = id & 31; *(LAS u32x4*)(qis + r * 528 + c * 16) = *(const GAS u32x4*)(Pb + (size_t)(32 * qt + r) * NPROJ + C_QI + 8 * c); }
    if (tid == 0) flag[0] = 0u;
    float wh[8];
    { const u32x4 ww = *(const GAS u32x4*)(Pb + (size_t)tq * NPROJ + C_WI);
      wh[0] = bflo(ww.x); wh[1] = bfhi(ww.x); wh[2] = bflo(ww.y); wh[3] = bfhi(ww.y); wh[4] = bflo(ww.z); wh[5] = bfhi(ww.z); wh[6] = bflo(ww.w); wh[7] = bfhi(ww.w);
#pragma unroll
      for (int h = 0; h < 8; ++h) wh[h] *= 0.0625f; }
    __syncthreads();
    const int nkt32 = qt + 1;
    const int nslots = (nkt32 - w + 7) >> 3;
    unsigned code[8][16];
#pragma unroll 1
    for (int rep_s = 0; rep_s < (PROBE_DSA == 1 ? 2 : 1); ++rep_s) {
    bf16x8 kfr[8][2];
#pragma unroll
    for (int j = 0; j < 8; ++j) { const int key0 = 32 * (w + 8 * j);
        kfr[j][0] = *(const GAS bf16x8*)(Pb + (size_t)(key0 + q) * NPROJ + C_KI + 8 * hi); kfr[j][1] = *(const GAS bf16x8*)(Pb + (size_t)(key0 + q) * NPROJ + C_KI + 16 + 8 * hi); }
#pragma unroll
    for (int j = 0; j < 8; ++j) {
#pragma unroll
        for (int r = 0; r < 16; ++r) code[j][r] = 0u;
        if (j < nslots) {
            const int key0 = 32 * (w + 8 * j);
            const bf16x8 k0 = kfr[j][0], k1 = kfr[j][1];
            float sc[16];
#pragma unroll
            for (int r = 0; r < 16; ++r) sc[r] = 0.f;
#pragma unroll
            for (int h = 0; h < 8; ++h) {
                const bf16x8 q0 = *(const LAS bf16x8*)(qis + q * 528 + h * 64 + hi * 16), q1 = *(const LAS bf16x8*)(qis + q * 528 + h * 64 + 32 + hi * 16);
                f32x16 a;
#pragma unroll
                for (int r = 0; r < 16; ++r) a[r] = 0.f;
                a = __builtin_amdgcn_mfma_f32_32x32x16_bf16(k0, q0, a, 0, 0, 0);
                a = __builtin_amdgcn_mfma_f32_32x32x16_bf16(k1, q1, a, 0, 0, 0);
#pragma unroll
                for (int r = 0; r < 16; ++r) { const float t = __builtin_amdgcn_fmed3f(a[r], 0.f, INFINITY); asm("v_fmac_f32_e32 %0, %1, %2" : "+v"(sc[r]) : "v"(wh[h]), "v"(t)); }
                __builtin_amdgcn_sched_barrier(0);
            }
#pragma unroll
            for (int r = 0; r < 16; ++r) { const float v = sc[r] + 0.0f; const unsigned ub = __float_as_uint(v); const unsigned mc = (ub & 0x80000000u) ? ~ub : (ub | 0x80000000u);
                code[j][r] = (key0 + crow(r, hi) <= tq) ? mc : 0u; }
        }
    }
    }
#pragma unroll 1
    for (int rep_t = 0; rep_t < (PROBE_DSA == 2 ? 2 : 1); ++rep_t) {
    LAS unsigned* T = (LAS unsigned*)F.lds;
    unsigned c2[4][32];
#pragma unroll
    for (int j = 0; j < 8; ++j) {
        __syncthreads();
#pragma unroll
        for (int r = 0; r < 16; ++r) T[q * 257 + 32 * w + crow(r, hi)] = code[j][r];
        __syncthreads();
#pragma unroll
        for (int i = 0; i < 4; ++i)
#pragma unroll
            for (int cc = 0; cc < 4; ++cc) c2[i][4 * j + cc] = T[(4 * w + i) * 257 + 64 * cc + lane];
    }
    __syncthreads();
    const int lane2 = lane_id();
    const int ncc = (32 * qt + 31) / 64 + 1;
    unsigned pfx[4] = {0u, 0u, 0u, 0u}; int cge[4] = {0x7fffffff, 0x7fffffff, 0x7fffffff, 0x7fffffff};
    for (int bit = 31; bit >= 0; --bit) {
        int cnt[4] = {0, 0, 0, 0};
        const unsigned cd0 = __builtin_amdgcn_readfirstlane(pfx[0] | (1u << bit)), cd1 = __builtin_amdgcn_readfirstlane(pfx[1] | (1u << bit)), cd2 = __builtin_amdgcn_readfirstlane(pfx[2] | (1u << bit)), cd3 = __builtin_amdgcn_readfirstlane(pfx[3] | (1u << bit));
        int nc = ncc; asm volatile("" : "+s"(nc));
        int n0 = 0, n1 = 0, n2 = 0, n3 = 0;
#define SEL_ONE(c) do { unsigned long long m0, m1, m2, m3; \
            asm volatile("v_cmp_le_u32_e64 %[m0], %[c0], %[x0]\n\tv_cmp_le_u32_e64 %[m1], %[c1], %[x1]\n\tv_cmp_le_u32_e64 %[m2], %[c2], %[x2]\n\tv_cmp_le_u32_e64 %[m3], %[c3], %[x3]\n\t" \
                         "v_addc_co_u32_e64 %[n0], %[m0], 0, %[n0], %[m0]\n\tv_addc_co_u32_e64 %[n1], %[m1], 0, %[n1], %[m1]\n\tv_addc_co_u32_e64 %[n2], %[m2], 0, %[n2], %[m2]\n\tv_addc_co_u32_e64 %[n3], %[m3], 0, %[n3], %[m3]" \
                         : [n0] "+v"(n0), [n1] "+v"(n1), [n2] "+v"(n2), [n3] "+v"(n3), [m0] "=&s"(m0), [m1] "=&s"(m1), [m2] "=&s"(m2), [m3] "=&s"(m3) \
                         : [c0] "s"(cd0), [c1] "s"(cd1), [c2] "s"(cd2), [c3] "s"(cd3), [x0] "v"(c2[0][c]), [x1] "v"(c2[1][c]), [x2] "v"(c2[2][c]), [x3] "v"(c2[3][c])); } while (0)
#pragma unroll
        for (int c = 0; c < 32; c += 8) if (c < nc) { SEL_ONE(c); SEL_ONE(c + 1); SEL_ONE(c + 2); SEL_ONE(c + 3); SEL_ONE(c + 4); SEL_ONE(c + 5); SEL_ONE(c + 6); SEL_ONE(c + 7); }
#undef SEL_ONE
        { int t01 = n0 | (n1 << 16), t23 = n2 | (n3 << 16);
          t01 = wave_sum_dpp(t01); t23 = wave_sum_dpp(t23);
          n0 = t01 & 0xffff; n1 = (int)((unsigned)t01 >> 16); n2 = t23 & 0xffff; n3 = (int)((unsigned)t23 >> 16); }
        cnt[0] = n0; cnt[1] = n1; cnt[2] = n2; cnt[3] = n3;
        if (cnt[0] >= 256) { pfx[0] = cd0; cge[0] = cnt[0]; } if (cnt[1] >= 256) { pfx[1] = cd1; cge[1] = cnt[1]; } if (cnt[2] >= 256) { pfx[2] = cd2; cge[2] = cnt[2]; } if (cnt[3] >= 256) { pfx[3] = cd3; cge[3] = cnt[3]; }
        if (cge[0] == 256 && cge[1] == 256 && cge[2] == 256 && cge[3] == 256) break;
    }
#pragma unroll
    for (int i = 0; i < 4; ++i) {
        const int ql = 4 * w + i;
        const unsigned pf = pfx[i];
        if (cge[i] == 256) {
#pragma unroll
            for (int c = 0; c < 32; ++c) { const unsigned long long sel = __ballot(c2[i][c] >= pf);
                if (lane2 < 2) maskw[ql * 65 + 2 * c + lane2] = lane2 ? (unsigned)(sel >> 32) : (unsigned)sel; }
            continue;
        }
        int cgt = 0; int nc = ncc; asm volatile("" : "+s"(nc));
#pragma unroll
        for (int c = 0; c < 32; ++c) if (c < nc) cgt += __builtin_popcountll(__ballot(c2[i][c] > pf));
        int need = 256 - cgt;
#pragma unroll
        for (int c = 0; c < 32; ++c) {
            unsigned long long sel = 0ull;
            if (c < nc) {
                sel = __ballot(c2[i][c] > pf);
                unsigned long long eq = __ballot(c2[i][c] == pf);
                int ne = __builtin_popcountll(eq);
                if (ne > need) { int drop = ne - need; while (drop > 0) { eq &= ~(1ull << (63 - __builtin_clzll(eq))); --drop; } ne = need; }
                need -= ne; sel |= eq;
            }
            if (lane2 < 2) maskw[ql * 65 + 2 * c + lane2] = lane2 ? (unsigned)(sel >> 32) : (unsigned)sel;
        }
    }
    __syncthreads();
    }
#pragma unroll 1
    for (int rep_f = 0; rep_f < (PROBE_DSA == 3 ? 2 : 1); ++rep_f)
    flash_block<0>(P, b, (32 * qt + 31) / 64 + 1, qt, C_QA + 64 * w, C_KA, C_VA, (bf16_t*)(F.ws + WS_OABC) + 64 * w, F.lds + A_V_OFF, maskw, 0u, w * 64 + lane_id());
}
__device__ __forceinline__ unsigned moba_select(const bf16_t* P, const float* km, int b, int h, int qt, int lane_) {
    int lane = lane_; asm volatile("" : "+v"(lane));
    const int q = lane & 31, hi = lane >> 5, tq = 32 * qt + q, own = qt >> 3;
    if (own == 0) return 0u;
    const GAS bf16_t* qp = (const GAS bf16_t*)P + (size_t)(b * SEQ + tq) * NPROJ + C_QC + 64 * h;
    float qv[32];
#pragma unroll
    for (int s = 0; s < 4; ++s) { const u32x4 w = *(const GAS u32x4*)(qp + 16 * s + 8 * hi);
        qv[8 * s] = bflo(w.x); qv[8 * s + 1] = bfhi(w.x); qv[8 * s + 2] = bflo(w.y); qv[8 * s + 3] = bfhi(w.y); qv[8 * s + 4] = bflo(w.z); qv[8 * s + 5] = bfhi(w.z); qv[8 * s + 6] = bflo(w.w); qv[8 * s + 7] = bfhi(w.w); }
    float g[7];
#pragma unroll
    for (int n = 0; n < 7; ++n) { g[n] = -INFINITY;
        { const GAS float* kp = (const GAS float*)km + ((size_t)(b * 8 + h) * 8 + n) * 64; float s = 0.f;
#pragma unroll
            for (int sgm = 0; sgm < 4; ++sgm) { const f32x4 k0 = *(const GAS f32x4*)(kp + 16 * sgm + 8 * hi) + *(const GAS f32x4*)(kp + 32768 + 16 * sgm + 8 * hi), k1 = *(const GAS f32x4*)(kp + 16 * sgm + 8 * hi + 4) + *(const GAS f32x4*)(kp + 32768 + 16 * sgm + 8 * hi + 4);
                s += qv[8 * sgm] * k0[0] + qv[8 * sgm + 1] * k0[1] + qv[8 * sgm + 2] * k0[2] + qv[8 * sgm + 3] * k0[3] + qv[8 * sgm + 4] * k1[0] + qv[8 * sgm + 5] * k1[1] + qv[8 * sgm + 6] * k1[2] + qv[8 * sgm + 7] * k1[3]; }
            s += __shfl_xor(s, 32); g[n] = s; } }
    unsigned sel = 0u;
#pragma unroll
    for (int n = 0; n < 7; ++n) { int rk = 0;
#pragma unroll
        for (int n2 = 0; n2 < 7; ++n2) rk += (n2 < own && n2 != n && (g[n2] > g[n] || (g[n2] == g[n] && n2 < n))) ? 1 : 0;
        if (n < own && rk < 3) sel |= 1u << n; }
    return sel;
}
__device__ __forceinline__ void ph_attn_a(Frame& F) {
    for (int p0_ = F.bid; p0_ < 256; p0_ += F.G) { const int p = GRP_MAJOR(p0_, F.G); const int b = p >> 5, j = p & 31;
#pragma unroll 1
        for (int u = 0; u < 2; ++u) dsa_unit(F, b, u ? 63 - j : j); }
}
__device__ __forceinline__ void ph_attn_bc(Frame& F) {
    const bf16_t* P = (const bf16_t*)(F.ws + WS_PROJ); const float* km = (const float*)(F.ws + WS_KMEAN);
    bf16_t* OB = (bf16_t*)(F.ws + WS_OABC) + (size_t)TOK * 512; bf16_t* OC = OB + (size_t)TOK * 512;
    const int w = F.wave;
    LAS unsigned char* kv = F.lds + A_V_OFF;
    for (int p0_ = F.bid; p0_ < 256; p0_ += F.G) { const int p = GRP_MAJOR(p0_, F.G); const int bh = p >> 2, b = bh >> 3, h = bh & 7, j = p & 3;
#pragma unroll 1
        for (int u = 0; u < 2; ++u) { const int qb = u ? 7 - j : j, qt = 8 * qb + w;
            flash_block<1>(P, b, 4 * (qb + 1), qt, C_QB + 64 * h, C_KB + 64 * h, C_VB + 64 * h, OB + 64 * h, kv, nullptr, 0u, F.tid);
            const unsigned sel = moba_select(P, km, b, h, qt, F.lane);
            flash_block<2>(P, b, 4 * (qb + 1), qt, C_QC + 64 * h, C_KC + 64 * h, C_VC + 64 * h, OC + 64 * h, kv, nullptr, sel, F.tid);
        } }
}

constexpr int NPL = 11, NPHASES = 1 + NL * NPL;
__global__ void __launch_bounds__(NTHREADS, 2) fwd(Args args) {
    extern __shared__ __attribute__((aligned(16))) unsigned char lds_raw[];
    Frame F;
    F.lds = (LAS unsigned char*)lds_raw; F.MISC = (volatile LAS unsigned*)(F.lds + LDS_MISC);
    F.tid = threadIdx.x; F.lane = F.tid & 63; F.wave = __builtin_amdgcn_readfirstlane(F.tid >> 6); F.G = gridDim.x; F.bid = blockIdx.x;
    const int wave0 = F.wave;
    F.out = args.out; F.ws = args.ws;
    for (int u = F.tid; u < 512; u += NTHREADS) F.MISC[u] = 0u;
    __syncthreads();
    XcdBarrier bar; bar.bar = (gu32*)(F.ws + WS_CTL); bar.x = 0; bar.st = nullptr;
    if (!MK_PER_PHASE) bar = xcd_barrier_post((gu32*)(F.ws + WS_CTL), F.MISC, F.tid == 0);
    if (!MK_PER_PHASE && F.tid == 0) __hip_atomic_store((gu32*)(F.ws + WS_CTL) + GB_XCC(F.bid), xb_xcc_id() + 1u, __ATOMIC_RELAXED, __HIP_MEMORY_SCOPE_AGENT);
    int loc_ok = 0; unsigned lgen = 0u;
    const int lo = args.ph_lo, hi = args.ph_hi;
#define IN(k) (lo <= (k) && (k) < hi)
#define RL() do { int l_ = lane_id(), w_ = wave0; asm volatile("" : "+v"(l_), "+s"(w_)); F.lane = l_; F.wave = w_; F.tid = w_ * 64 + l_; \
        unsigned char* ws_ = args.ws; float* out_ = args.out; asm volatile("" : "+s"(ws_), "+s"(out_)); F.ws = ws_; F.out = out_; } while (0)
#define SEAM(k) do { if (IN(k) && IN((k) + 1)) xcd_barrier(bar, wave0); } while (0)
#define SEAML(k) do { if (IN(k) && IN((k) + 1)) { if (loc_ok) { ++lgen; grp_barrier((gu32*)(args.ws + WS_CTL), (int)(blockIdx.x & 7), 32u * lgen, wave0, lane_id()); } else xcd_barrier(bar, wave0); } } while (0)
    if (HAS(11) && IN(0)) { RL(); ph_ada_rope(F, args); __syncthreads(); ph_convert(F, args, 0); }
    SEAM(0);
    if (!MK_PER_PHASE && XCD_LOCAL && IN(0) && IN(1)) {
        if (wave0 == 0) { const int l_ = lane_id(); bool ok = (gridDim.x == 256u); gu32* ctl = (gu32*)(args.ws + WS_CTL);
#pragma unroll
            for (int j = 0; j < 4; ++j) { const int c = l_ + 64 * j; const unsigned v = xb_ld(ctl + GB_XCC(c)), r = xb_ld(ctl + GB_XCC(c & 7)); ok = ok && (v != 0u) && (v == r); }
            const bool all = (__ballot(!ok) == 0ull);
            if (l_ == 0) F.MISC[4] = all ? 1u : 0u; }
        __syncthreads();
        loc_ok = __builtin_amdgcn_readfirstlane((int)F.MISC[4]);
    }
    for (int l = 0; l < NL; ++l) {
        const int pb = 1 + l * NPL;
        const float* xin = (l == 0) ? INP(I_X) : (const float*)F.out;
        if (HAS(0) && IN(pb + 0)) for (int rep_ = 0; rep_ < NREP(0); ++rep_) { RL(); if (rep_ > 0) xcd_barrier(bar, wave0); if (l == 0) ph_modulate(F, INP(I_X), 0); else ph_convert(F, args, l); }
        if (l == 0) SEAML(pb + 0); else SEAM(pb + 0);
#if EN_MIX
        if (HAS(1) && IN(pb + 1)) for (int rep_ = 0; rep_ < NREP(1); ++rep_) { RL(); if (rep_ > 0) xcd_barrier(bar, wave0);
            ProbDense S{(const char*)(F.ws + WS_U), (const char*)(F.ws + WS_WIN), DM, TOK / 256, NPROJ / 256, F.G, F.bid};
            EpiProj E{(bf16_t*)(F.ws + WS_PROJ), (const float*)(F.ws + WS_COS64), (const float*)(F.ws + WS_SIN64), (const float*)(F.ws + WS_COS32), (const float*)(F.ws + WS_SIN32), INP(I_IKG) + l * 32, INP(I_IKB) + l * 32, (float*)(F.ws + WS_KMEAN)};
            pg8::gemm_phase(F.lds, S, E, F.tid);
        }
        SEAML(pb + 1);
        if (HAS(2) && IN(pb + 2)) for (int rep_ = 0; rep_ < NREP(2); ++rep_) { RL(); if (rep_ > 0) xcd_barrier(bar, wave0); ph_attn_a(F); }
        if (HAS(3) && IN(pb + 3)) for (int rep_ = 0; rep_ < NREP(3); ++rep_) { RL(); if (rep_ > 0) xcd_barrier(bar, wave0); ph_attn_bc(F); }
        SEAML(pb + 3);
        if (HAS(4) && IN(pb + 4)) for (int rep_ = 0; rep_ < NREP(4); ++rep_) { RL(); if (rep_ > 0) xcd_barrier(bar, wave0);
            ProbBranch S{(const char*)(F.ws + WS_OABC), (const char*)(F.ws + WS_WBR), 512, F.G, F.bid};
            EpiBranch E{(const bf16_t*)(F.ws + WS_PROJ), (bf16_t*)(F.ws + WS_MERGED)};
            pg8::gemm_phase(F.lds, S, E, F.tid);
        }
        SEAML(pb + 4);
        if (HAS(5) && IN(pb + 5)) for (int rep_ = 0; rep_ < NREP(5); ++rep_) { RL(); if (rep_ > 0) xcd_barrier(bar, wave0);
            ProbDense S{(const char*)(F.ws + WS_MERGED), (const char*)(F.ws + WS_WOUT), DM, TOK / 256, DM / 256, F.G, F.bid};
            EpiY E{(bf16_t*)(F.ws + WS_OABC)};
            pg8::gemm_phase(F.lds, S, E, F.tid);
        }
        SEAML(pb + 5);
#endif
        if (HAS(6) && IN(pb + 6)) for (int rep_ = 0; rep_ < NREP(6); ++rep_) { RL(); if (rep_ > 0) xcd_barrier(bar, wave0); }
        if (HAS(7) && IN(pb + 7)) for (int rep_ = 0; rep_ < NREP(7); ++rep_) { RL(); if (rep_ > 0) xcd_barrier(bar, wave0); ph_router(F, args, xin, l); }
        SEAM(pb + 7);
        if (HAS(8) && IN(pb + 8)) for (int rep_ = 0; rep_ < NREP(8); ++rep_) { RL(); if (rep_ > 0) xcd_barrier(bar, wave0);
            load_expert_tables(F, l);
            ProbGrouped<2, true> S{(const char*)(F.ws + WS_U), (const char*)(F.ws + WS_WGU), DM, F.G, F.bid, F.MISC, (const int*)(F.ws + WS_LTOK), (size_t)512 * DM * 2, F.wave};
            EpiGateUp E{(bf16_t*)(F.ws + WS_H), (const float*)(F.ws + WS_LW), F.MISC};
            pg8::gemm_phase(F.lds, S, E, F.tid);
        }
        SEAM(pb + 8);
        if (HAS(9) && IN(pb + 9)) for (int rep_ = 0; rep_ < NREP(9); ++rep_) { RL(); if (rep_ > 0) xcd_barrier(bar, wave0);
            load_expert_tables(F, l);
            ProbGrouped<4, false> S{(const char*)(F.ws + WS_H), (const char*)(F.ws + WS_WD), EDIM, F.G, F.bid, F.MISC, nullptr, (size_t)DM * EDIM * 2, F.wave};
            EpiDown E{F.ws + WS_Y, (bf16_t*)(F.ws + WS_U), F.MISC, F.ws + WS_KMEAN + 131072};
            pg8::gemm_phase(F.lds, S, E, F.tid);
        }
        SEAM(pb + 9);
        if (HAS(10) && IN(pb + 10)) for (int rep_ = 0; rep_ < NREP(10); ++rep_) { RL(); if (rep_ > 0) xcd_barrier(bar, wave0); ph_combine(F, args, l); }
    }
#undef IN
#undef SEAM
}

extern "C" void kernel_launch(void* const* d_in, const int* in_sizes, int n_in, void* d_out, int out_size, void* d_ws, size_t ws_size, hipStream_t stream) {
    static int grid = 0;
    if (grid == 0) {
        if (n_in != 23 || out_size != TOK * DM || ws_size < WS_END) { fprintf(stderr, "kernel_launch: unexpected shapes (n_in %d, out %d, ws %zu < %zu)\n", n_in, out_size, ws_size, (size_t)WS_END); grid = -1; return; }
        int dev = 0, cus = 0, per_cu = 0;
        if (hipGetDevice(&dev) != hipSuccess || hipDeviceGetAttribute(&cus, hipDeviceAttributeMultiprocessorCount, dev) != hipSuccess) { grid = -1; return; }
        if (hipFuncSetAttribute((const void*)fwd, hipFuncAttributeMaxDynamicSharedMemorySize, LDS_BYTES) != hipSuccess) { fprintf(stderr, "kernel_launch: hipFuncSetAttribute failed\n"); grid = -1; return; }
        if (hipOccupancyMaxActiveBlocksPerMultiprocessor(&per_cu, (const void*)fwd, NTHREADS, LDS_BYTES) != hipSuccess || per_cu < 1) { fprintf(stderr, "kernel_launch: occupancy query says %d\n", per_cu); }
        (void)hipGetLastError();
        grid = cus;
    }
    if (grid < 0) return;
    (void)hipMemsetAsync((char*)d_ws + WS_CTL, 0, CTL_ZERO_BYTES, stream);
    Args a{};
    for (int i = 0; i < 23; ++i) a.in[i] = (const float*)d_in[i];
    a.out = (float*)d_out; a.ws = (unsigned char*)d_ws;
#if MK_PER_PHASE
    for (int p = 0; p < NPHASES; ++p) { a.ph_lo = p; a.ph_hi = p + 1; hipLaunchKernelGGL(fwd, dim3(grid), dim3(NTHREADS), LDS_BYTES, stream, a); }
#else
    a.ph_lo = 0; a.ph_hi = NPHASES;
    hipLaunchKernelGGL(fwd, dim3(grid), dim3(NTHREADS), LDS_BYTES, stream, a);
#endif
}
```

```cpp
#include <hip/hip_runtime.h>
#include <stdint.h>
#include <stdio.h>

#ifndef MK_PER_PHASE
#ifndef XCD_LOCAL
#define XCD_LOCAL 1
#endif
#define MK_PER_PHASE 0
#endif
#ifndef PH_MASK
#define PH_MASK 0xFFFF
#endif
#define HAS(k) (((PH_MASK) >> (k)) & 1)
#ifndef PROBE_PHASE
#define PROBE_PHASE (-1)
#endif
#ifndef PROBE_N
#define PROBE_N 0
#endif
#define NREP(k) (((k) == PROBE_PHASE) ? (1 + PROBE_N) : 1)
#ifndef PROBE_DSA
#define PROBE_DSA 0
#endif
#ifndef EN_MIX
#define EN_MIX 1
#endif

#define LAS __attribute__((address_space(3)))
#define GAS __attribute__((address_space(1)))
typedef unsigned short bf16_t;
typedef short bf16x8 __attribute__((ext_vector_type(8)));
typedef short s16x4 __attribute__((ext_vector_type(4)));
typedef float f32x2 __attribute__((ext_vector_type(2)));
typedef float f32x4 __attribute__((ext_vector_type(4)));
typedef float f32x16 __attribute__((ext_vector_type(16)));
typedef unsigned u32x4 __attribute__((ext_vector_type(4)));
typedef unsigned u32x2 __attribute__((ext_vector_type(2)));
typedef __bf16 bf16x2_t __attribute__((ext_vector_type(2)));

constexpr int NBATCH = 8, SEQ = 2048, TOK = NBATCH * SEQ, DM = 1024, NL = 2;
constexpr int NPROJ = 7168, NEXP = 64, EDIM = 256, TOPK = 8;
constexpr float LN_EPS = 1e-5f, ALPHA = 1.41421356237309515f;
constexpr float QSCALE = 0.125f * 1.4426950408889634f;
constexpr float Y8_SCALE = 16.0f;
constexpr int C_QA = 0, C_QB = 512, C_KB = 1024, C_VB = 1536, C_QC = 2048, C_KC = 2560, C_VC = 3072;
constexpr int C_GA = 3584, C_GB = 4608, C_GC = 5632, C_QI = 6656, C_KA = 6912, C_VA = 6976, C_KI = 7040, C_WI = 7072;

constexpr size_t MiB = 1u << 20;
constexpr size_t WS_CTL = 0, CTL_ZERO_BYTES = 65536;
constexpr size_t CTL_CNT_OFF = 16384;
constexpr size_t WS_MOD = 1 * MiB;
constexpr size_t WS_COS64 = 2 * MiB, WS_SIN64 = WS_COS64 + 262144, WS_COS32 = WS_SIN64 + 262144, WS_SIN32 = WS_COS32 + 131072;
constexpr size_t WS_KMEAN = 3 * MiB;
constexpr size_t WS_TOKE = 3 * MiB + 256 * 1024, WS_TOKP = WS_TOKE + 524288;
constexpr size_t WS_LTOK = 5 * MiB, WS_LW = 9 * MiB;
constexpr size_t WS_WIN = 16 * MiB, WS_WBR = 30 * MiB, WS_WOUT = 33 * MiB, WS_WGU = 36 * MiB, WS_WD = 101 * MiB;
constexpr size_t WS_U = 134 * MiB;
constexpr size_t WS_PROJ = 166 * MiB;
constexpr size_t WS_OABC = 390 * MiB;
constexpr size_t WS_MERGED = 438 * MiB;
constexpr size_t WS_SHO = WS_OABC;
constexpr size_t WS_Y = WS_PROJ;
constexpr size_t WS_H = WS_PROJ + 128 * MiB;
constexpr size_t WS_XB = WS_MERGED + (size_t)TOK * DM * 2;
constexpr size_t WS_END = WS_XB + (size_t)TOK * DM * 2;
static_assert(WS_Y + (size_t)131072 * 2048 <= WS_MERGED, "Y overlay");
static_assert(WS_END <= 512 * MiB, "workspace");
static_assert(WS_H + (size_t)(147456 + 256) * 512 <= WS_OABC && WS_Y + (size_t)131072 * 1024 <= WS_H, "H overlay");

constexpr int LDS_MAIN = 133120;
constexpr int LDS_MISC = 133120;
constexpr int LDS_TEX = LDS_MISC + 2048;
constexpr int LDS_BYTES = LDS_TEX + 1024;
constexpr int NTHREADS = 512;

__device__ __forceinline__ unsigned cvtpk(float lo, float hi) { f32x2 v = {lo, hi}; bf16x2_t b = __builtin_convertvector(v, bf16x2_t); return __builtin_bit_cast(unsigned, b); }
__device__ __forceinline__ float bf2f(unsigned short b) { return __uint_as_float(((unsigned)b) << 16); }
__device__ __forceinline__ float bflo(unsigned w) { return __uint_as_float(w << 16); }
__device__ __forceinline__ float bfhi(unsigned w) { return __uint_as_float(w & 0xffff0000u); }
__device__ __forceinline__ float sigmoidf_(float x) { return __builtin_amdgcn_rcpf(1.0f + __expf(-x)); }
#define GRP_MAJOR(c, G) (((G) == 256) ? ((((c) & 7) << 5) | ((c) >> 3)) : (c))
#define LDS_WAIT() asm volatile("s_waitcnt lgkmcnt(0)" ::: "memory")
#define VM_WAIT() asm volatile("s_waitcnt vmcnt(0)" ::: "memory")

#define XB_TMO      128
#define XB_XCNT(j)  (256  + 64 * (j))
#define XB_XSUB(j)  (1280 + 64 * (j))
#define XB_XGEN(j)  (2304 + 64 * (j))
#define XB_TOP      3328
#define XB_TOPGEN   3392
#define XCD_BAR_WORDS 3456
#define XB_SPIN_CAP (1u << 22)
typedef GAS unsigned gu32;
__device__ __forceinline__ unsigned xb_ld(gu32* p)              { return __hip_atomic_load(p, __ATOMIC_RELAXED, __HIP_MEMORY_SCOPE_AGENT); }
__device__ __forceinline__ unsigned xb_add(gu32* p, unsigned v) { return __hip_atomic_fetch_add(p, v, __ATOMIC_RELAXED, __HIP_MEMORY_SCOPE_AGENT); }
__device__ __forceinline__ unsigned xb_xcc_id() { return (unsigned)__builtin_amdgcn_s_getreg((3 << 11) | 20) & 0xFu; }
#define XB_SPIN(cond, bar) do { unsigned _sp = 0; while (cond) { __builtin_amdgcn_s_sleep(1); \
    if ((++_sp & 255u) == 0u) { if (xb_ld(&(bar)[XB_TMO])) break; if (_sp > XB_SPIN_CAP) { xb_add(&(bar)[XB_TMO], 1u); break; } } } } while (0)
struct XcdBarrier { gu32* bar; unsigned x; volatile LAS unsigned* st; };
#define GB_CNT(g)  (8192 + 64 * (g))
#define GB_XCC(c)  (10240 + (c))
__device__ __forceinline__ void grp_barrier(gu32* ctl_, int g, unsigned target, int wave0, int lane0) {
    gu32* ctl = ctl_; asm volatile("" : "+s"(ctl));
    asm volatile("s_waitcnt vmcnt(0)" ::: "memory");
    __syncthreads();
    if (wave0 == 0 && lane0 == 0) {
        gu32* cnt = ctl + GB_CNT(g);
        (void)__hip_atomic_fetch_add(cnt, 1u, __ATOMIC_RELAXED, __HIP_MEMORY_SCOPE_WORKGROUP);
        unsigned sp = 0;
        while (xb_ld(cnt) < target) { __builtin_amdgcn_s_sleep(1); if (++sp > XB_SPIN_CAP) break; }
        __builtin_amdgcn_fence(__ATOMIC_ACQUIRE, "agent");
        asm volatile("s_waitcnt vmcnt(0)" ::: "memory");
    }
    __syncthreads();
}
__device__ __forceinline__ XcdBarrier xcd_barrier_post(gu32* bar, volatile LAS unsigned* st, bool leader) {
    XcdBarrier b; b.bar = bar; b.x = xb_xcc_id(); b.st = st;
    if (leader) (void)xb_add(&bar[XB_XCNT(b.x)], 1u);
    return b;
}
__device__ __forceinline__ void xcd_barrier_complete(gu32* bar, unsigned x, unsigned& nloc, unsigned& nx) {
    const unsigned G = gridDim.x * gridDim.y * gridDim.z;
    unsigned sum, cnt, mine, sp = 0u;
    for (;;) {
        sum = 0u; cnt = 0u; mine = 0u;
#pragma unroll
        for (unsigned j = 0; j < 16; ++j) { const unsigned c = xb_ld(&bar[XB_XCNT(j)]); sum += c; cnt += (c > 0u) ? 1u : 0u; mine = (j == x) ? c : mine; }
        if (sum == G) break;
        __builtin_amdgcn_s_sleep(1);
        if ((++sp & 255u) == 0u) { if (xb_ld(&bar[XB_TMO])) break; if (sp > XB_SPIN_CAP) { xb_add(&bar[XB_TMO], 1u); break; } }
    }
    nloc = mine > 0u ? mine : 1u; nx = cnt > 0u ? cnt : 1u;
}
__device__ __forceinline__ int lane_id() { unsigned z; asm volatile("s_mov_b32 %0, 0" : "=s"(z)); return (int)__builtin_amdgcn_mbcnt_hi(~0u, __builtin_amdgcn_mbcnt_lo(~0u, z)); }
__device__ __forceinline__ void xcd_barrier_impl(gu32* bar_, unsigned bx, volatile LAS unsigned* st, int wave0) {
    gu32* bar = bar_; asm volatile("" : "+s"(bar));
    asm volatile("s_waitcnt vmcnt(0)" ::: "memory");
    __syncthreads();
    if (wave0 == 0 && lane_id() == 0) {
        __builtin_amdgcn_s_waitcnt(0);
        unsigned nloc = st[0], nx = st[1];
        if (nloc == 0u) { xcd_barrier_complete(bar, bx, nloc, nx); st[0] = nloc; st[1] = nx; }
        const unsigned old = xb_add(&bar[XB_XSUB(bx)], 1u);
        const unsigned gen = old / nloc;
        if (old + 1u == (gen + 1u) * nloc) {
            __builtin_amdgcn_fence(__ATOMIC_RELEASE, "agent");
            asm volatile("s_waitcnt vmcnt(0)" ::: "memory");
            const unsigned og = xb_add(&bar[XB_TOP], 1u);
            const unsigned tg = og / nx;
            if (og + 1u == (tg + 1u) * nx) xb_add(&bar[XB_TOPGEN], 1u);
            else XB_SPIN(xb_ld(&bar[XB_TOPGEN]) == tg, bar);
            __builtin_amdgcn_fence(__ATOMIC_ACQUIRE, "agent");
            xb_add(&bar[XB_XGEN(bx)], 1u);
            asm volatile("s_waitcnt vmcnt(0)" ::: "memory");
        } else {
            XB_SPIN(xb_ld(&bar[XB_XGEN(bx)]) == gen, bar);
            __builtin_amdgcn_fence(__ATOMIC_ACQUIRE, "agent");
            asm volatile("s_waitcnt vmcnt(0)" ::: "memory");
        }
    }
    __syncthreads();
}
__device__ __forceinline__ void xcd_barrier(const XcdBarrier& b, int wave0) { xcd_barrier_impl(b.bar, b.x, b.st, wave0); }

struct Args { const float* in[23]; float* out; unsigned char* ws; int ph_lo, ph_hi; };
struct Frame {
    LAS unsigned char* lds;
    volatile LAS unsigned* MISC;
    int tid, lane, wave, G, bid;
    float* out; unsigned char* ws;
};
#define INP(i) (args.in[(i)])
enum { I_X = 0, I_C, I_ADAW, I_ADAB, I_WIN, I_IKG, I_IKB, I_WBRA, I_WBRB, I_WBRC, I_WOUT, I_LN1G, I_LN1B, I_WR, I_RB, I_WG, I_WU, I_WDN, I_SG, I_SU, I_SD, I_LN2G, I_LN2B };
__device__ __forceinline__ float wave_sum(float v) {
    v += __int_as_float(__builtin_amdgcn_update_dpp(0, __float_as_int(v), 0xB1, 0xF, 0xF, true));
    v += __int_as_float(__builtin_amdgcn_update_dpp(0, __float_as_int(v), 0x4E, 0xF, 0xF, true));
    v += __int_as_float(__builtin_amdgcn_update_dpp(0, __float_as_int(v), 0x141, 0xF, 0xF, true));
    v += __int_as_float(__builtin_amdgcn_update_dpp(0, __float_as_int(v), 0x140, 0xF, 0xF, true));
    const int vi = __float_as_int(v);
    return (__int_as_float(__builtin_amdgcn_readlane(vi, 0)) + __int_as_float(__builtin_amdgcn_readlane(vi, 16))) + (__int_as_float(__builtin_amdgcn_readlane(vi, 32)) + __int_as_float(__builtin_amdgcn_readlane(vi, 48)));
}

__device__ __forceinline__ void ph_ada_rope(Frame& F, const Args& args) {
    LAS float* sc = (LAS float*)F.lds;
    LAS float* part = (LAS float*)(F.lds + 32768);
    const float* c = INP(I_C);
    for (int idx = F.tid; idx < 8192; idx += NTHREADS) { const int k = idx >> 3, b = idx & 7; const float x = c[b * DM + k]; sc[idx] = x / (1.0f + __expf(-x)); }
    __syncthreads();
    float* mod = (float*)(F.ws + WS_MOD);
    for (int item = F.bid; item < 192; item += F.G) {
        const int l = item / 96, n0 = (item % 96) * 64;
        const GAS float* w = (const GAS float*)(INP(I_ADAW)) + (size_t)l * DM * 6144 + n0 + F.lane;
        float acc[8];
#pragma unroll
        for (int b = 0; b < 8; ++b) acc[b] = 0.f;
        const int kb = F.wave * 128;
#pragma unroll 8
        for (int k = 0; k < 128; ++k) {
            const float wv = __builtin_nontemporal_load(w + (size_t)(kb + k) * 6144);
            const f32x4 s0 = *(const LAS f32x4*)(sc + (kb + k) * 8), s1 = *(const LAS f32x4*)(sc + (kb + k) * 8 + 4);
            acc[0] += s0[0] * wv; acc[1] += s0[1] * wv; acc[2] += s0[2] * wv; acc[3] += s0[3] * wv;
            acc[4] += s1[0] * wv; acc[5] += s1[1] * wv; acc[6] += s1[2] * wv; acc[7] += s1[3] * wv;
        }
#pragma unroll
        for (int b = 0; b < 8; ++b) part[(F.wave * 8 + b) * 64 + F.lane] = acc[b];
        __syncthreads();
        { const int b = F.tid >> 6, n = F.tid & 63; float s = 0.f;
#pragma unroll
          for (int w8 = 0; w8 < 8; ++w8) s += part[(w8 * 8 + b) * 64 + n];
          mod[((size_t)l * 8 + b) * 6144 + n0 + n] = s + INP(I_ADAB)[l * 6144 + n0 + n]; }
        __syncthreads();
    }
    { float* c64 = (float*)(F.ws + WS_COS64); float* s64 = (float*)(F.ws + WS_SIN64); float* c32 = (float*)(F.ws + WS_COS32); float* s32 = (float*)(F.ws + WS_SIN32);
      for (int idx = F.bid * NTHREADS + F.tid; idx < SEQ * 48; idx += F.G * NTHREADS) {
          if (idx < SEQ * 32) { const int t = idx >> 5, i = idx & 31; const float inv = powf(10000.0f, -(float)(2 * i) / 64.0f); const float ang = (float)t * inv;
              c64[idx] = (float)cos((double)ang); s64[idx] = (float)sin((double)ang); }
          else { const int j = idx - SEQ * 32; const int t = j >> 4, i = j & 15; const float inv = powf(10000.0f, -(float)(2 * i) / 32.0f); const float ang = (float)t * inv;
              c32[j] = (float)cos((double)ang); s32[j] = (float)sin((double)ang); }
      } }
}

__device__ __forceinline__ int win_src_of_true(int tc) {
    if (tc < 512) return tc;
    if (tc < 1024) return 936 + (tc - 512);
    if (tc < 1536) return 1448 + (tc - 1024);
    if (tc < 2048) return 1960 + (tc - 1536);
    if (tc < 2560) return 2472 + (tc - 2048);
    if (tc < 3072) return 2984 + (tc - 2560);
    if (tc < 3584) return 3496 + (tc - 3072);
    if (tc < 4608) return 4008 + (tc - 3584);
    if (tc < 5632) return 5032 + (tc - 4608);
    if (tc < 6656) return 6056 + (tc - 5632);
    if (tc < 6912) return 640 + (tc - 6656);
    if (tc < 6976) return 512 + (tc - 6912);
    if (tc < 7040) return 576 + (tc - 6976);
    if (tc < 7072) return 896 + (tc - 7040);
    if (tc < 7080) return 928 + (tc - 7072);
    return -1;
}
__device__ __forceinline__ int proj_true_of_gemm(int g) {
    const int pn = g >> 8, gl = g & 255, bj = gl >> 7, wc = (gl >> 5) & 3, y = gl & 31;
    if (pn == 26) return pn * 256 + 32 * (2 * wc + (y >> 4)) + 16 * bj + (y & 15);
    return pn * 256 + 64 * wc + 32 * bj + y;
}
struct CJob { const float* src; bf16_t* dst; int src_ld, k0, scol, dst_ld, n0; };
__device__ __forceinline__ void conv_load(const CJob& j, f32x4 (&v)[16], int lane) {
    const int rq = lane >> 4;
    const GAS float* sp = (const GAS float*)j.src + (size_t)(j.k0 + rq) * j.src_ld + (j.scol < 0 ? 0 : j.scol);
#pragma unroll
    for (int i = 0; i < 16; ++i) v[i] = (j.scol < 0) ? (f32x4){0.f, 0.f, 0.f, 0.f} : __builtin_nontemporal_load((const GAS f32x4*)(sp + (size_t)(4 * i) * j.src_ld));
}
__device__ __forceinline__ void conv_store(const CJob& j, const f32x4 (&v)[16], LAS float* scr, int lane) {
    const int rq = lane >> 4, c4 = (lane & 15) * 4;
#pragma unroll
    for (int i = 0; i < 16; ++i) { const int k = 4 * i + rq;
#pragma unroll
        for (int jj = 0; jj < 4; ++jj) scr[(c4 + jj) * 65 + k] = v[i][jj]; }
    LDS_WAIT();
#pragma unroll
    for (int i = 0; i < 8; ++i) { const int n = (lane >> 3) + 8 * i, c = lane & 7; const LAS float* sp = scr + n * 65 + 8 * c;
        u32x4 o; o.x = cvtpk(sp[0], sp[1]); o.y = cvtpk(sp[2], sp[3]); o.z = cvtpk(sp[4], sp[5]); o.w = cvtpk(sp[6], sp[7]);
        *(GAS u32x4*)(j.dst + (size_t)(j.n0 + n) * j.dst_ld + j.k0 + 8 * c) = o; }
    LDS_WAIT();
}
constexpr int CT_WIN = 16 * 112, CT_WBR = 3 * 8 * 16, CT_WOUT = 256, CT_WGU = 65 * 16 * 8, CT_WD = 65 * 4 * 16, CT_ALL = CT_WIN + CT_WBR + CT_WOUT + CT_WGU + CT_WD;
__device__ __forceinline__ void conv_kn(int r, int NB, int& kb, int& nb) { const int grp = r >> 3, w8 = r & 7, nbg = NB >> 2; kb = 2 * (grp / nbg) + (w8 >> 2); nb = 4 * (grp % nbg) + (w8 & 3); }
__device__ __forceinline__ CJob conv_job(const Args& args, unsigned char* ws, int l, int it, int lane) {
    const int c4 = (lane & 15) * 4; CJob j; int r = it;
    if (r < CT_WIN) { int kb, nb; conv_kn(r, 112, kb, nb); const int g = nb * 64 + c4;
        j.src = INP(I_WIN) + (size_t)l * DM * 7080; j.src_ld = 7080; j.k0 = kb * 64; j.scol = win_src_of_true(proj_true_of_gemm(g)); j.dst = (bf16_t*)(ws + WS_WIN); j.dst_ld = DM; j.n0 = nb * 64; return j; }
    r -= CT_WIN;
    if (r < CT_WBR) { const int br = r / 128, q = r % 128; int kb, nb; conv_kn(q, 16, kb, nb);
        j.src = (br == 0 ? INP(I_WBRA) : (br == 1 ? INP(I_WBRB) : INP(I_WBRC))) + (size_t)l * 512 * DM; j.src_ld = DM; j.k0 = kb * 64; j.scol = nb * 64 + c4;
        j.dst = (bf16_t*)(ws + WS_WBR) + (size_t)br * DM * 512; j.dst_ld = 512; j.n0 = nb * 64; return j; }
    r -= CT_WBR;
    if (r < CT_WOUT) { int kb, nb; conv_kn(r, 16, kb, nb);
        j.src = INP(I_WOUT) + (size_t)l * DM * DM; j.src_ld = DM; j.k0 = kb * 64; j.scol = nb * 64 + c4; j.dst = (bf16_t*)(ws + WS_WOUT); j.dst_ld = DM; j.n0 = nb * 64; return j; }
    r -= CT_WOUT;
    if (r < CT_WGU) { const int e = r / 128, q = r % 128; int kb, nb; conv_kn(q, 8, kb, nb);
        const int g = nb * 64 + c4, pn = g >> 8, bj = (g >> 7) & 1, x = g & 127, f = 128 * pn + x;
        j.src = (e < 64) ? ((bj ? INP(I_WU) : INP(I_WG)) + ((size_t)l * 64 + e) * DM * EDIM) : ((bj ? INP(I_SU) : INP(I_SG)) + (size_t)l * DM * EDIM);
        j.src_ld = EDIM; j.k0 = kb * 64; j.scol = f; j.dst = (bf16_t*)(ws + WS_WGU) + (size_t)e * 512 * DM; j.dst_ld = DM; j.n0 = nb * 64; return j; }
    r -= CT_WGU;
    { const int e = r / 64, q = r % 64; int kb, nb; conv_kn(q, 16, kb, nb);
        const int g = nb * 64 + c4, tn = (g & ~255) + 64 * ((g >> 5) & 3) + 16 * ((g >> 3) & 3) + 8 * ((g >> 7) & 1) + (g & 7);
        j.src = (e < 64) ? (INP(I_WDN) + ((size_t)l * 64 + e) * EDIM * DM) : (INP(I_SD) + (size_t)l * EDIM * DM);
        j.src_ld = DM; j.k0 = kb * 64; j.scol = tn; j.dst = (bf16_t*)(ws + WS_WD) + (size_t)e * DM * EDIM; j.dst_ld = EDIM; j.n0 = nb * 64; return j; }
}
constexpr int CT_DENSE = CT_WIN + CT_WBR + CT_WOUT;
__device__ __forceinline__ void ph_convert(Frame& F, const Args& args, int l, const int lo, const int CT_HI) {
    LAS float* scr = (LAS float*)(F.lds + F.wave * 16640);
    const int gw = F.bid * 8 + F.wave, NGW = F.G * 8, lane = F.lane;
    int it = lo + gw;
    if (it >= CT_HI) return;
    CJob cur = conv_job(args, F.ws, l, it, lane);
    f32x4 va[16], vb[16];
    conv_load(cur, va, lane);
    for (;;) {
        const int it2 = it + NGW; const bool more = it2 < CT_HI;
        CJob nxt = cur;
        if (more) { nxt = conv_job(args, F.ws, l, it2, lane); conv_load(nxt, vb, lane); }
        conv_store(cur, va, scr, lane);
        if (!more) break;
        const int it3 = it2 + NGW; const bool more2 = it3 < CT_HI;
        cur = nxt;
        if (more2) { cur = conv_job(args, F.ws, l, it3, lane); conv_load(cur, va, lane); }
        conv_store(nxt, vb, scr, lane);
        if (!more2) break;
        it = it3;
    }
}

__device__ __forceinline__ void ph_modulate(Frame& F, const float* x, int l) {
    const float* mod = (const float*)(F.ws + WS_MOD) + (size_t)l * 8 * 6144;
    bf16_t* U = (bf16_t*)(F.ws + WS_U);
    const int gw = F.bid * 8 + F.wave, NGW = F.G * 8;
#pragma unroll 1
    for (int m0 = gw; m0 < TOK; m0 += 2 * NGW) {
        f32x4 xv[2][4], sc[2][4], sh[2][4];
#pragma unroll
        for (int r = 0; r < 2; ++r) { const int m = (m0 + r * NGW < TOK) ? m0 + r * NGW : m0; const int b = m >> 11;
#pragma unroll
            for (int j = 0; j < 4; ++j) { xv[r][j] = __builtin_nontemporal_load((const GAS f32x4*)(x + (size_t)m * DM) + F.lane + 64 * j);
                sc[r][j] = *((const GAS f32x4*)(mod + b * 6144 + DM) + F.lane + 64 * j); sh[r][j] = *((const GAS f32x4*)(mod + b * 6144) + F.lane + 64 * j); } }
#pragma unroll
        for (int r = 0; r < 2; ++r) { const int m = m0 + r * NGW; if (m < TOK) {
            GAS u32x2* o = (GAS u32x2*)(U + (size_t)m * DM) + F.lane;
#pragma unroll
            for (int j = 0; j < 4; ++j) { const f32x4 u = xv[r][j] * (1.0f + sc[r][j]) + sh[r][j]; u32x2 w; w.x = cvtpk(u[0], u[1]); w.y = cvtpk(u[2], u[3]); o[64 * j] = w; } } }
    }
}
constexpr int RT_PITCH = 4096 + 16;
struct Ln1Rows { f32x4 xf[4][4]; u32x2 xb[4][4]; u32x2 yv[4][4]; };
template <bool XF32>
__device__ __forceinline__ void ln1_load(Frame& F, const float* x, int m0, Ln1Rows& R) {
    const bf16_t* Yb = (const bf16_t*)(F.ws + WS_OABC); const bf16_t* XB = (const bf16_t*)(F.ws + WS_XB);
#pragma unroll
    for (int i = 0; i < 4; ++i) { const int m = m0 + 8 * i;
#pragma unroll
        for (int j = 0; j < 4; ++j) {
            R.yv[i][j] = (u32x2){0u, 0u};
            if (EN_MIX) R.yv[i][j] = __builtin_nontemporal_load((const GAS u32x2*)(Yb + (size_t)(j >> 1) * TOK * 512 + (size_t)m * 512) + F.lane + 64 * (j & 1));
            if (XF32) R.xf[i][j] = __builtin_nontemporal_load((const GAS f32x4*)(x + (size_t)m * DM) + F.lane + 64 * j);
            else R.xb[i][j] = __builtin_nontemporal_load((const GAS u32x2*)(XB + (size_t)m * DM) + F.lane + 64 * j); } }
}
template <bool XF32>
__device__ __forceinline__ void ln1_rows(Frame& F, const Args& args, int l, int m0, const Ln1Rows& R, LAS unsigned char* stage, int m_base) {
    const float* mod = (const float*)(F.ws + WS_MOD) + (size_t)l * 8 * 6144;
    bf16_t* U = (bf16_t*)(F.ws + WS_U); bf16_t* XB = (bf16_t*)(F.ws + WS_XB);
    const int b = m0 >> 11;
    f32x4 g1v[4];
#pragma unroll
    for (int j = 0; j < 4; ++j) g1v[j] = *((const GAS f32x4*)(mod + b * 6144 + 2 * DM) + F.lane + 64 * j);
    f32x4 v[4][4]; float rstd[4];
#pragma unroll
    for (int i = 0; i < 4; ++i) { float s = 0.f;
#pragma unroll
        for (int j = 0; j < 4; ++j) { const u32x2 yw = R.yv[i][j]; const f32x4 y = {bflo(yw.x), bfhi(yw.x), bflo(yw.y), bfhi(yw.y)};
            f32x4 xv;
            if (XF32) xv = R.xf[i][j]; else { const u32x2 xw = R.xb[i][j]; xv = (f32x4){bflo(xw.x), bfhi(xw.x), bflo(xw.y), bfhi(xw.y)}; }
            v[i][j] = xv * ALPHA + (1.0f + g1v[j]) * y; s += (v[i][j][0] + v[i][j][1]) + (v[i][j][2] + v[i][j][3]); }
        const float mean = wave_sum(s) * (1.f / DM); float s2 = 0.f;
#pragma unroll
        for (int j = 0; j < 4; ++j) { v[i][j] = v[i][j] - mean; s2 += (v[i][j][0] * v[i][j][0] + v[i][j][1] * v[i][j][1]) + (v[i][j][2] * v[i][j][2] + v[i][j][3] * v[i][j][3]); }
        rstd[i] = 1.f / sqrtf(wave_sum(s2) * (1.f / DM) + LN_EPS);
        __builtin_amdgcn_sched_barrier(0);
    }
#pragma unroll
    for (int j = 0; j < 4; ++j) {
        const f32x4 lgj = *((const GAS f32x4*)(INP(I_LN1G) + l * DM) + F.lane + 64 * j), lbj = *((const GAS f32x4*)(INP(I_LN1B) + l * DM) + F.lane + 64 * j);
        const f32x4 scj = *((const GAS f32x4*)(mod + b * 6144 + 4 * DM) + F.lane + 64 * j), shj = *((const GAS f32x4*)(mod + b * 6144 + 3 * DM) + F.lane + 64 * j);
#pragma unroll
        for (int i = 0; i < 4; ++i) { const int m = m0 + 8 * i;
            const f32x4 x1 = v[i][j] * rstd[i] * lgj + lbj; u32x2 xw; xw.x = cvtpk(x1[0], x1[1]); xw.y = cvtpk(x1[2], x1[3]);
            *((GAS u32x2*)(XB + (size_t)m * DM) + F.lane + 64 * j) = xw;
            const f32x4 u = x1 * (1.0f + scj) + shj; u32x2 w; w.x = cvtpk(u[0], u[1]); w.y = cvtpk(u[2], u[3]);
            *((GAS u32x2*)(U + (size_t)m * DM) + F.lane + 64 * j) = w;
            *((LAS f32x4*)(stage + (m - m_base) * RT_PITCH) + F.lane + 64 * j) = u; }
    }
}
__device__ __forceinline__ void load_expert_tables(Frame& F, int l) {
    if (F.wave == 0) {
        const gu32* cnt = (const gu32*)((const unsigned*)(F.ws + WS_CTL + CTL_CNT_OFF) + l * 64);
        const int e = lane_id();
        const unsigned c = __hip_atomic_load(cnt + e, __ATOMIC_RELAXED, __HIP_MEMORY_SCOPE_AGENT);
        unsigned so = c, to = (c + 255u) >> 8;
#pragma unroll
        for (int o = 1; o < 64; o <<= 1) { const unsigned a_ = (unsigned)__shfl_up((int)so, o), b_ = (unsigned)__shfl_up((int)to, o); if (e >= o) { so += a_; to += b_; } }
        F.MISC[32 + e] = so - c; F.MISC[128 + e] = to - ((c + 255u) >> 8); F.MISC[256 + e] = c;
        if (e == 63) { F.MISC[32 + 64] = 131072u; F.MISC[128 + 64] = to; F.MISC[128 + 65] = to + 64u; F.MISC[256 + 64] = TOK; }
        { volatile LAS unsigned char* tex = (volatile LAS unsigned char*)F.MISC + 2048; const unsigned t0 = to - ((c + 255u) >> 8), nt_ = (c + 255u) >> 8;
          for (unsigned k = 0; k < nt_; ++k) tex[t0 + k] = (unsigned char)e;
          const unsigned tot_ = (unsigned)__builtin_amdgcn_readlane((int)to, 63); tex[tot_ + (unsigned)e] = (unsigned char)64; }
    }
    __syncthreads();
}
struct CmbRow { u32x4 yw[8]; u32x4 s0, s1, x0, x1; };
__device__ __forceinline__ void cmb_load(Frame& F, int m, const int (&sl)[8], CmbRow& R) {
    const unsigned char* Y8 = F.ws + WS_Y;
#pragma unroll
    for (int k = 0; k < TOPK; ++k) R.yw[k] = __builtin_nontemporal_load((const GAS u32x4*)(Y8 + (size_t)(unsigned)sl[k] * DM) + F.lane);
    { const GAS u32x4* ys = (const GAS u32x4*)((const bf16_t*)(F.ws + WS_SHO) + (size_t)m * DM) + 2 * F.lane; R.s0 = __builtin_nontemporal_load(ys); R.s1 = __builtin_nontemporal_load(ys + 1); }
    { const GAS u32x4* xs = (const GAS u32x4*)((const bf16_t*)(F.ws + WS_XB) + (size_t)m * DM) + 2 * F.lane; R.x0 = __builtin_nontemporal_load(xs); R.x1 = __builtin_nontemporal_load(xs + 1); }
}
__device__ __forceinline__ int cmb_slotv(Frame& F, int m) {
    const GAS int* toke = (const GAS int*)(F.ws + WS_TOKE); const GAS int* tokp = (const GAS int*)(F.ws + WS_TOKP);
    const int k = F.lane & 7;
    const int e = toke[m * 8 + k], p = tokp[m * 8 + k];
    return (int)((const LAS unsigned*)F.MISC)[32 + e] + p;
}
struct CmbPar { f32x4 g2[4], lg[4], lb[4], sh[4], sc[4]; };
__device__ __forceinline__ void cmb_row(Frame& F, const Args& args, int l, int m, const CmbRow& R, const CmbPar& Q) {
    bf16_t* U = (bf16_t*)(F.ws + WS_U);
    typedef float f32x2v __attribute__((ext_vector_type(2)));
    f32x4 racc[4];
#pragma unroll
    for (int j = 0; j < 4; ++j) racc[j] = (f32x4){0.f, 0.f, 0.f, 0.f};
#pragma unroll
    for (int k = 0; k < TOPK; ++k) { const u32x4 w = R.yw[k];
#pragma unroll
        for (int j = 0; j < 4; ++j) { const f32x2v lo = __builtin_amdgcn_cvt_pk_f32_fp8((int)w[j], false), hi = __builtin_amdgcn_cvt_pk_f32_fp8((int)w[j], true);
            racc[j] += (f32x4){lo[0], lo[1], hi[0], hi[1]}; } }
    f32x4 acc[4];
    { const u32x4 w0 = R.s0, w1 = R.s1;
      acc[0] = (f32x4){bflo(w0.x), bfhi(w0.x), bflo(w0.y), bfhi(w0.y)}; acc[1] = (f32x4){bflo(w0.z), bfhi(w0.z), bflo(w0.w), bfhi(w0.w)};
      acc[2] = (f32x4){bflo(w1.x), bfhi(w1.x), bflo(w1.y), bfhi(w1.y)}; acc[3] = (f32x4){bflo(w1.z), bfhi(w1.z), bflo(w1.w), bfhi(w1.w)}; }
#pragma unroll
    for (int j = 0; j < 4; ++j) acc[j] += racc[j] * (1.0f / Y8_SCALE);
    f32x4 xr[4];
    { const u32x4 w0 = R.x0, w1 = R.x1;
      xr[0] = (f32x4){bflo(w0.x), bfhi(w0.x), bflo(w0.y), bfhi(w0.y)}; xr[1] = (f32x4){bflo(w0.z), bfhi(w0.z), bflo(w0.w), bfhi(w0.w)};
      xr[2] = (f32x4){bflo(w1.x), bfhi(w1.x), bflo(w1.y), bfhi(w1.y)}; xr[3] = (f32x4){bflo(w1.z), bfhi(w1.z), bflo(w1.w), bfhi(w1.w)}; }
    f32x4 v[4]; float s = 0.f;
#pragma unroll
    for (int j = 0; j < 4; ++j) { v[j] = xr[j] * ALPHA + (1.0f + Q.g2[j]) * acc[j]; s += (v[j][0] + v[j][1]) + (v[j][2] + v[j][3]); }
    const float mean = wave_sum(s) * (1.f / DM); float s2 = 0.f;
#pragma unroll
    for (int j = 0; j < 4; ++j) { v[j] = v[j] - mean; s2 += (v[j][0] * v[j][0] + v[j][1] * v[j][1]) + (v[j][2] * v[j][2] + v[j][3] * v[j][3]); }
    const float rstd = 1.f / sqrtf(wave_sum(s2) * (1.f / DM) + LN_EPS);
    GAS f32x4* xo = (GAS f32x4*)(F.out + (size_t)m * DM) + 4 * F.lane; GAS u32x4* uo = (GAS u32x4*)(U + (size_t)m * DM) + 2 * F.lane;
    f32x4 un[4];
#pragma unroll
    for (int j = 0; j < 4; ++j) { const f32x4 x2 = v[j] * rstd * Q.lg[j] + Q.lb[j]; if (l + 1 >= NL) xo[j] = x2; un[j] = x2; xr[j] = x2;
        if (l + 1 < NL) un[j] = x2 * (1.0f + Q.sc[j]) + Q.sh[j]; }
    if (l + 1 < NL) { u32x4 w0, w1;
        w0.x = cvtpk(un[0][0], un[0][1]); w0.y = cvtpk(un[0][2], un[0][3]); w0.z = cvtpk(un[1][0], un[1][1]); w0.w = cvtpk(un[1][2], un[1][3]);
        w1.x = cvtpk(un[2][0], un[2][1]); w1.y = cvtpk(un[2][2], un[2][3]); w1.z = cvtpk(un[3][0], un[3][1]); w1.w = cvtpk(un[3][2], un[3][3]);
        uo[0] = w0; uo[1] = w1;
        GAS u32x4* xbo = (GAS u32x4*)((bf16_t*)(F.ws + WS_XB) + (size_t)m * DM) + 2 * F.lane;
        w0.x = cvtpk(xr[0][0], xr[0][1]); w0.y = cvtpk(xr[0][2], xr[0][3]); w0.z = cvtpk(xr[1][0], xr[1][1]); w0.w = cvtpk(xr[1][2], xr[1][3]);
        w1.x = cvtpk(xr[2][0], xr[2][1]); w1.y = cvtpk(xr[2][2], xr[2][3]); w1.z = cvtpk(xr[3][0], xr[3][1]); w1.w = cvtpk(xr[3][2], xr[3][3]);
        xbo[0] = w0; xbo[1] = w1; }
}
__device__ __forceinline__ void ph_combine(Frame& F, const Args& args, int l, bool have_tab) {
    if (!have_tab) load_expert_tables(F, l);
    for (int blk = F.bid; blk < TOK / 64; blk += F.G) {
        const int m0 = blk * 64 + F.wave, b = m0 >> 11; constexpr int nrow = 8, STEP = 8;
        CmbPar Q;
        { const float* mod = (const float*)(F.ws + WS_MOD) + (size_t)l * 8 * 6144; const float* modn = (const float*)(F.ws + WS_MOD) + (size_t)(l + 1 < NL ? l + 1 : l) * 8 * 6144;
#pragma unroll
          for (int j = 0; j < 4; ++j) { Q.g2[j] = *((const GAS f32x4*)(mod + b * 6144 + 5 * DM) + 4 * F.lane + j);
              Q.lg[j] = *((const GAS f32x4*)(INP(I_LN2G) + l * DM) + 4 * F.lane + j); Q.lb[j] = *((const GAS f32x4*)(INP(I_LN2B) + l * DM) + 4 * F.lane + j);
              Q.sh[j] = *((const GAS f32x4*)(modn + b * 6144) + 4 * F.lane + j); Q.sc[j] = *((const GAS f32x4*)(modn + b * 6144 + DM) + 4 * F.lane + j); } }
        CmbRow RA, RB; int sl[8];
        int svA = cmb_slotv(F, m0), svB = cmb_slotv(F, m0 + STEP);
#pragma unroll
        for (int k = 0; k < 8; ++k) sl[k] = __builtin_amdgcn_readlane(svA, k);
        cmb_load(F, m0, sl, RA);
#pragma unroll 1
        for (int r = 0; r < nrow; r += 2) {
            const int m = m0 + r * STEP;
            if (r + 2 < nrow) svA = cmb_slotv(F, m + 2 * STEP);
            {
#pragma unroll
                for (int k = 0; k < 8; ++k) sl[k] = __builtin_amdgcn_readlane(svB, k);
                cmb_load(F, m + STEP, sl, RB); }
            cmb_row(F, args, l, m, RA, Q);
            if (r + 3 < nrow) svB = cmb_slotv(F, m + 3 * STEP);
            if (r + 2 < nrow) {
#pragma unroll
                for (int k = 0; k < 8; ++k) sl[k] = __builtin_amdgcn_readlane(svA, k);
                cmb_load(F, m + 2 * STEP, sl, RA); }
            cmb_row(F, args, l, m + STEP, RB, Q);
        }
    }
}

template <bool XF32>
__device__ __forceinline__ void ph_router(Frame& F, const Args& args, const float* xin, int l) {
    const float* mod = (const float*)(F.ws + WS_MOD) + (size_t)l * 8 * 6144;
    const float* Wr = INP(I_WR) + (size_t)l * DM * 64;
    const float* rb = INP(I_RB) + l * 64;
    unsigned* gcnt = (unsigned*)(F.ws + WS_CTL + CTL_CNT_OFF) + l * 64;
    GAS int* toke = (GAS int*)(F.ws + WS_TOKE); GAS int* tokp = (GAS int*)(F.ws + WS_TOKP);
    GAS int* ltok = (GAS int*)(F.ws + WS_LTOK); GAS float* lw = (GAS float*)(F.ws + WS_LW);
    LAS float* part = (LAS float*)F.lds;
    volatile LAS unsigned* lcnt = F.MISC + 384;
    const int lane = F.lane, i = lane & 31, kk = lane >> 5;
    for (int item0_ = F.bid; item0_ < TOK / 64; item0_ += F.G) {
        const int item = GRP_MAJOR(item0_, F.G);
        const int t0 = item * 64, b = t0 >> 11;
        f32x16 acc[2][2];
#pragma unroll
        for (int a = 0; a < 2; ++a)
#pragma unroll
            for (int c = 0; c < 2; ++c)
#pragma unroll
                for (int r = 0; r < 16; ++r) acc[a][c][r] = 0.f;
        const int kb = F.wave * 128;
        Ln1Rows RA, RB;
        ln1_load<XF32>(F, xin, t0 + F.wave, RA);
#pragma unroll
        for (int rt = 0; rt < 2; ++rt) {
            ln1_rows<XF32>(F, args, l, t0 + 32 * rt + F.wave, rt ? RB : RA, F.lds, t0 + 32 * rt);
            __syncthreads();
            if (rt == 0) ln1_load<XF32>(F, xin, t0 + 32 + F.wave, RB);
#pragma unroll 4
            for (int it = 0; it < 16; ++it) {
                const int k4 = kb + 8 * it + 4 * kk;
                const f32x4 a4 = *(const LAS f32x4*)(F.lds + i * RT_PITCH + 4 * k4);
                float bv[2][4];
#pragma unroll
                for (int s = 0; s < 4; ++s) { bv[0][s] = ((const GAS float*)Wr)[(size_t)(k4 + s) * 64 + i]; bv[1][s] = ((const GAS float*)Wr)[(size_t)(k4 + s) * 64 + 32 + i]; }
#pragma unroll
                for (int s = 0; s < 4; ++s)
#pragma unroll
                    for (int ct = 0; ct < 2; ++ct) acc[rt][ct] = __builtin_amdgcn_mfma_f32_32x32x2f32(a4[s], bv[ct][s], acc[rt][ct], 0, 0, 0);
            }
            __syncthreads();
        }
#pragma unroll
        for (int rt = 0; rt < 2; ++rt)
#pragma unroll
            for (int ct = 0; ct < 2; ++ct)
#pragma unroll
                for (int r = 0; r < 16; ++r) { const int tk = 32 * rt + (r & 3) + 8 * (r >> 2) + 4 * kk; part[(F.wave * 64 + tk) * 65 + 32 * ct + i] = acc[rt][ct][r]; }
        if (F.tid < 64) lcnt[F.tid] = 0u;
        __syncthreads();
        const int tk = F.tid >> 3, eg = F.tid & 7, t = t0 + tk;
        float sg[8], bs[8];
#pragma unroll
        for (int j = 0; j < 8; ++j) { float s = 0.f;
#pragma unroll
            for (int w8 = 0; w8 < 8; ++w8) s += part[(w8 * 64 + tk) * 65 + 8 * eg + j];
            sg[j] = sigmoidf_(s); bs[j] = sg[j] + rb[8 * eg + j]; }
        float m1 = -INFINITY, m2 = -INFINITY;
#pragma unroll
        for (int j = 0; j < 8; ++j) { const float v = bs[j]; if (v > m1) { m2 = m1; m1 = v; } else if (v > m2) m2 = v; }
        const float gs = m1 + m2;
        int grank = 0;
#pragma unroll 1
        for (int d = 0; d < 8; ++d) { const float og = __shfl(gs, (lane & ~7) + d); grank += (og > gs || (og == gs && d < eg)) ? 1 : 0; }
        const bool gsel = grank < 4;
        float cv[8];
#pragma unroll
        for (int j = 0; j < 8; ++j) cv[j] = gsel ? bs[j] : -INFINITY;
        int rank[8];
#pragma unroll
        for (int j = 0; j < 8; ++j) rank[j] = 0;
#pragma unroll 1
        for (int d = 0; d < 8; ++d)
#pragma unroll
            for (int jj = 0; jj < 8; ++jj) { const float ov = __shfl(cv[jj], (lane & ~7) + d); const int oi = 8 * d + jj;
#pragma unroll
                for (int j = 0; j < 8; ++j) rank[j] += (ov > cv[j] || (ov == cv[j] && oi < 8 * eg + j)) ? 1 : 0; }
        unsigned selm = 0; float wsum = 0.f;
#pragma unroll
        for (int j = 0; j < 8; ++j) { const bool s = gsel && rank[j] < TOPK; selm |= s ? (1u << j) : 0u; wsum += s ? sg[j] : 0.f; }
        wsum += __shfl_xor(wsum, 1); wsum += __shfl_xor(wsum, 2); wsum += __shfl_xor(wsum, 4);
        const int nsel = __popc(selm); int pre = 0;
#pragma unroll 1
        for (int d = 0; d < 8; ++d) { const int on = __shfl(nsel, (lane & ~7) + d); pre += (d < eg) ? on : 0; }
        const float wscale = 2.5f / wsum;
        int lp[8];
#pragma unroll
        for (int j = 0; j < 8; ++j) { lp[j] = 0; if (selm & (1u << j)) lp[j] = (int)atomicAdd((unsigned*)(lcnt + 8 * eg + j), 1u); }
        __syncthreads();
        if (F.tid < 64) lcnt[64 + F.tid] = atomicAdd(gcnt + F.tid, lcnt[F.tid]);
        __syncthreads();
        int kslot = pre;
#pragma unroll
        for (int j = 0; j < 8; ++j) if (selm & (1u << j)) { const int e = 8 * eg + j; const int pos = (int)lcnt[64 + e] + lp[j];
            toke[t * 8 + kslot] = e; tokp[t * 8 + kslot] = pos; ltok[e * TOK + pos] = t; lw[e * TOK + pos] = sg[j] * wscale; ++kslot; }
        __syncthreads();
    }
}

namespace pg8 {
constexpr int BM = 256, BK = 64, HALF = 128, HTB = HALF * BK * 2, STAGE_BYTES = 8 * HTB, NXCD = 8, WGM = 8;
__host__ __device__ __forceinline__ int lds_byte(int r, int c) { const int st = (r >> 4) * 2 + (c >> 5), rr = r & 15, cc = c & 31, ob = rr * 64 + cc * 2; return st * 1024 + (ob ^ (((ob >> 9) & 1) << 5)); }
__host__ __device__ __forceinline__ void stage_rc(int b, int& R, int& C) { const int st = b / 1024, sb = b % 1024, swz = sb ^ (((sb >> 9) & 1) << 5); R = (st >> 1) * 16 + swz / 64; C = (st & 1) * 32 + (swz % 64) / 2; }
__host__ __device__ __forceinline__ int perm32(int rho) { const int n = rho >> 4, i = rho & 15; return 8 * (i >> 2) + 4 * n + (i & 3); }
struct Unit { int pm, pn, e; };
__device__ __forceinline__ bool static_tile(int L, int nM, int nN, int& pm, int& pn) {
    const int nwg = nM * nN; if (L >= nwg) return false;
    int wgid = L; { const int q = nwg / NXCD, r = nwg % NXCD, xcd = wgid % NXCD, off = wgid / NXCD; wgid = (xcd < r ? xcd * (q + 1) : r * (q + 1) + (xcd - r) * q) + off; }
    const int nig = WGM * nN, gid = wgid / nig, fm = gid * WGM, gsz = (nM - fm) < WGM ? (nM - fm) : WGM;
    pm = fm + ((wgid % nig) % gsz); pn = (wgid % nig) / gsz; return true;
}
template <class T, class = void> struct epi_chain { static constexpr bool value = false; };
template <class T> struct epi_chain<T, decltype((void)T::CHAIN)> { static constexpr bool value = T::CHAIN; };
template <class T, class = void> struct epi_pre { static constexpr bool value = false; };
template <class T> struct epi_pre<T, decltype((void)T::PRE)> { static constexpr bool value = T::PRE; };
template <class P, class Epi>
__device__ __forceinline__ void gemm_phase(LAS unsigned char* lds, const P& S, const Epi& E, int tid) {
    constexpr bool GA = P::GATHER;
    const int wid = __builtin_amdgcn_readfirstlane(tid >> 6), lane = tid & 63, wr = wid >> 2, wc = wid & 3, fr = lane & 15, fq = lane >> 4;
    const int K = S.K, nt = K / BK;
    unsigned voffB[2], va[2];
#pragma unroll
    for (int i = 0; i < 2; ++i) { int R, C; stage_rc(tid * 16 + i * 8192, R, C); const int Rb = (R & ~31) + perm32(R & 31); voffB[i] = (unsigned)(Rb * K + C) * 2u; va[i] = (unsigned)(R * K + C) * 2u; }
    const size_t kstep = (size_t)(BK * 2);
    const size_t hstepB = (size_t)HALF * K * 2;
    const size_t hstepA = GA ? (size_t)0 : hstepB;
    const unsigned ldsw = (unsigned)wid * 1024u;
    const int aoff = lds_byte(wr * 64 + fr, fq * 8), boff = lds_byte(wc * 32 + fr, fq * 8);
#define PG8_SA(b, h) (((b) * 2 + (h)) * HTB)
#define PG8_SB(b, h) ((4 + (b) * 2 + (h)) * HTB)
#define PG8_STAGE2(bufoff, gbase, v0, v1) do { \
        __builtin_amdgcn_global_load_lds((const unsigned*)((const char*)(gbase) + (v0)), (LAS unsigned*)(lds + (bufoff) + ldsw), 16, 0, 0); \
        __builtin_amdgcn_global_load_lds((const unsigned*)((const char*)(gbase) + (v1)), (LAS unsigned*)(lds + (bufoff) + ldsw + 8192), 16, 0, 0); } while (0)
#define PG8_STAGEB(bufoff, gbase) PG8_STAGE2(bufoff, gbase, voffB[0], voffB[1])
#define PG8_STAGEA(bufoff, gbase, h, nx) do { if constexpr (GA) { const unsigned _v0 = (nx) ? nv[h][0] : cv[h][0], _v1 = (nx) ? nv[h][1] : cv[h][1]; PG8_STAGE2(bufoff, gbase, _v0, _v1); } \
        else { PG8_STAGE2(bufoff, (gbase) + (h) * hstepA, va[0], va[1]); } } while (0)
#define PG8_LDA(dst, b, h) do { _Pragma("unroll") for (int m = 0; m < 4; ++m) _Pragma("unroll") for (int k = 0; k < 2; ++k) dst[m][k] = *(const LAS bf16x8*)(lds + PG8_SA(b, h) + aoff + m * 2048 + k * 1024); } while (0)
#define PG8_LDB(dst, b, h) do { _Pragma("unroll") for (int n = 0; n < 2; ++n) _Pragma("unroll") for (int k = 0; k < 2; ++k) dst[n][k] = *(const LAS bf16x8*)(lds + PG8_SB(b, h) + boff + n * 2048 + k * 1024); } while (0)
#define PG8_MMA(ai, bj, At, Bt) do { __builtin_amdgcn_s_setprio(1); _Pragma("unroll") for (int m = 0; m < 4; ++m) _Pragma("unroll") for (int n = 0; n < 2; ++n) _Pragma("unroll") for (int k = 0; k < 2; ++k) \
        acc[ai][bj][m][n] = __builtin_amdgcn_mfma_f32_16x16x32_bf16(Bt[n][k], At[m][k], acc[ai][bj][m][n], 0, 0, 0); __builtin_amdgcn_s_setprio(0); } while (0)
#define PG8_WAIT_V(n) asm volatile("s_waitcnt vmcnt(" #n ")" ::: "memory")
#define PG8_WAIT_L(n) asm volatile("s_waitcnt lgkmcnt(" #n ")" ::: "memory")
#define PG8_BAR __builtin_amdgcn_s_barrier()
#define PG8_SCHED __builtin_amdgcn_sched_barrier(0)
    Unit cur, nxt; int ui = 0;
    if (!S.next(0, cur)) return;
    f32x4 acc[2][2][4][2];
#pragma unroll
    for (int a = 0; a < 2; ++a)
#pragma unroll
        for (int b = 0; b < 2; ++b)
#pragma unroll
            for (int m = 0; m < 4; ++m)
#pragma unroll
                for (int n = 0; n < 2; ++n) acc[a][b][m][n] = (f32x4){0.f, 0.f, 0.f, 0.f};
    bf16x8 At[4][2], B0[2][2], B1[2][2];
    const char* cA = S.a_base(cur); const char* cB = S.b_base(cur);
    unsigned cv[2][2], nv[2][2];
    if constexpr (GA) { S.a_voff(cur, cv);
#pragma unroll
        for (int h = 0; h < 2; ++h)
#pragma unroll
            for (int i = 0; i < 2; ++i) nv[h][i] = cv[h][i]; }
    PG8_STAGEB(PG8_SB(0, 0), cB); PG8_STAGEB(PG8_SB(0, 1), cB + hstepB); PG8_STAGEA(PG8_SA(0, 0), cA, 0, false); PG8_STAGEA(PG8_SA(0, 1), cA, 1, false);
    if (wr == 1) PG8_BAR;
    PG8_WAIT_V(2); PG8_BAR;
    PG8_STAGEB(PG8_SB(1, 0), cB + kstep); PG8_STAGEA(PG8_SA(1, 0), cA + kstep, 0, false); PG8_STAGEB(PG8_SB(1, 1), cB + hstepB + kstep);
    PG8_WAIT_V(6); PG8_BAR;
    for (;;) {
        const bool has_next = S.next(ui + 1, nxt);
        const char* nA = cA; const char* nB = cB;
        if (has_next) { nA = S.a_base(nxt); nB = S.b_base(nxt); if constexpr (GA) S.a_voff(nxt, nv); }
        float pre0 = 0.f, pre1 = 0.f;
        if constexpr (epi_pre<Epi>::value) E.pre(cur, wr, lane_id(), pre0, pre1);
        for (int t = 0; t < nt; t += 2) {
            const bool last = (t == nt - 2);
            const char* a1 = cA + (size_t)(t + 1) * kstep;
            const char* a2 = last ? nA : cA + (size_t)(t + 2) * kstep; const char* b2 = last ? nB : cB + (size_t)(t + 2) * kstep;
            const char* a3 = a2 + kstep; const char* b3 = b2 + kstep;
            const int relax_i = __builtin_amdgcn_readfirstlane(((Epi::NST > 0) && (t == 0) && (ui > 0)) ? 1 : 0);
            PG8_LDB(B0, 0, 0); PG8_LDB(B1, 0, 1); PG8_SCHED; PG8_LDA(At, 0, 0); PG8_STAGEA(PG8_SA(1, 1), a1, 1, false);
            if constexpr (Epi::NST == 16) { asm volatile("s_cmp_eq_u32 %0, 0\n\ts_cbranch_scc1 1f\n\ts_waitcnt vmcnt(24)\n\ts_branch 2f\n1:\n\ts_waitcnt vmcnt(8)\n2:" :: "s"(relax_i) : "scc", "memory"); } else if constexpr (Epi::NST == 8) { asm volatile("s_cmp_eq_u32 %0, 0\n\ts_cbranch_scc1 1f\n\ts_waitcnt vmcnt(16)\n\ts_branch 2f\n1:\n\ts_waitcnt vmcnt(8)\n2:" :: "s"(relax_i) : "scc", "memory"); } else PG8_WAIT_V(8);
            PG8_WAIT_L(0); PG8_BAR; PG8_MMA(0, 0, At, B0); PG8_MMA(0, 1, At, B1); PG8_BAR; PG8_SCHED;
            PG8_LDA(At, 0, 1); PG8_STAGEB(PG8_SB(0, 0), b2); PG8_STAGEB(PG8_SB(0, 1), b2 + hstepB); PG8_STAGEA(PG8_SA(0, 0), a2, 0, last);
            if constexpr (Epi::NST == 16) { asm volatile("s_cmp_eq_u32 %0, 0\n\ts_cbranch_scc1 1f\n\ts_waitcnt vmcnt(24)\n\ts_branch 2f\n1:\n\ts_waitcnt vmcnt(8)\n2:" :: "s"(relax_i) : "scc", "memory"); } else if constexpr (Epi::NST == 8) { asm volatile("s_cmp_eq_u32 %0, 0\n\ts_cbranch_scc1 1f\n\ts_waitcnt vmcnt(16)\n\ts_branch 2f\n1:\n\ts_waitcnt vmcnt(8)\n2:" :: "s"(relax_i) : "scc", "memory"); } else PG8_WAIT_V(8);
            PG8_WAIT_L(0); PG8_BAR; PG8_MMA(1, 0, At, B0); PG8_MMA(1, 1, At, B1); PG8_BAR; PG8_SCHED;
            PG8_LDB(B0, 1, 0); PG8_LDB(B1, 1, 1); PG8_SCHED; PG8_LDA(At, 1, 0); PG8_STAGEA(PG8_SA(0, 1), a2, 1, last);
            PG8_WAIT_V(8); PG8_WAIT_L(0); PG8_BAR; PG8_MMA(0, 0, At, B0); PG8_MMA(0, 1, At, B1); PG8_BAR; PG8_SCHED;
            PG8_LDA(At, 1, 1); PG8_STAGEB(PG8_SB(1, 0), b3); PG8_STAGEB(PG8_SB(1, 1), b3 + hstepB); PG8_STAGEA(PG8_SA(1, 0), a3, 0, last);
            PG8_WAIT_V(8); PG8_WAIT_L(0); PG8_BAR; PG8_MMA(1, 0, At, B0); PG8_MMA(1, 1, At, B1); PG8_BAR; PG8_SCHED;
        }
        if (wr == 0) PG8_BAR;
        { const int le = lane_id(); if constexpr (epi_pre<Epi>::value) E(acc, cur, wr, wc, le & 15, le >> 4, pre0, pre1); else E(acc, cur, wr, wc, le & 15, le >> 4); }
        if (!has_next) break;
        bool carry = false;
        if constexpr (epi_chain<Epi>::value) carry = (cur.e < 2);
        if (!carry) {
#pragma unroll
        for (int a = 0; a < 2; ++a)
#pragma unroll
            for (int b = 0; b < 2; ++b)
#pragma unroll
                for (int m = 0; m < 4; ++m)
#pragma unroll
                    for (int n = 0; n < 2; ++n) acc[a][b][m][n] = (f32x4){0.f, 0.f, 0.f, 0.f};
        }
        cur = nxt; cA = nA; cB = nB; ++ui;
        if constexpr (GA) {
#pragma unroll
            for (int h = 0; h < 2; ++h)
#pragma unroll
                for (int i = 0; i < 2; ++i) cv[h][i] = nv[h][i]; }
        if (wr == 1) PG8_BAR;
    }
    PG8_WAIT_V(0);
    PG8_BAR;
#undef PG8_SA
#undef PG8_SB
#undef PG8_STAGE2
#undef PG8_STAGEB
#undef PG8_STAGEA
#undef PG8_LDA
#undef PG8_LDB
#undef PG8_MMA
#undef PG8_WAIT_V
#undef PG8_WAIT_L
#undef PG8_BAR
#undef PG8_SCHED
}
__device__ __forceinline__ void dense_voff(int K, unsigned (&v)[2][2]) {
#pragma unroll
    for (int i = 0; i < 2; ++i) { int R, C; stage_rc((int)threadIdx.x * 16 + i * 8192, R, C);
        v[0][i] = (unsigned)(R * K + C) * 2u; v[1][i] = (unsigned)((R + HALF) * K + C) * 2u; }
}
}

struct ProbDense {
    static constexpr bool GATHER = false;
    const char* A; const char* Bt; int K, nM, nN, G, c;
    __device__ __forceinline__ bool next(int i, pg8::Unit& u) const { u.e = 0; return pg8::static_tile(i * G + c, nM, nN, u.pm, u.pn); }
    __device__ __forceinline__ const char* a_base(const pg8::Unit& u) const { return A + (size_t)u.pm * 256 * K * 2; }
    __device__ __forceinline__ const char* b_base(const pg8::Unit& u) const { return Bt + (size_t)u.pn * 256 * K * 2; }
};
struct ProbBranch {
    static constexpr bool GATHER = false;
    const char* A; const char* Bt; int K, G, c;
    __device__ __forceinline__ bool next(int i, pg8::Unit& u) const { u.e = i % 3; return pg8::static_tile((i / 3) * G + c, 64, 4, u.pm, u.pn); }
    __device__ __forceinline__ const char* a_base(const pg8::Unit& u) const { return A + ((size_t)u.e * TOK + (size_t)u.pm * 256) * 512 * 2; }
    __device__ __forceinline__ const char* b_base(const pg8::Unit& u) const { return Bt + ((size_t)u.e * DM + (size_t)u.pn * 256) * 512 * 2; }
};
template <int NPN, bool GATHER_> struct ProbGrouped {
    static constexpr bool GATHER = GATHER_;
    const char* A; const char* Bt; int K; int G, c; volatile LAS unsigned* MISC; const int* ltok; size_t b_estride; int tid;
    __device__ __forceinline__ bool next(int i, pg8::Unit& u) const {
        const int tot = (int)MISC[128 + 65];
        int tl;
        if (NPN == 4 && G == 256) {
            const int g = c & 7, pg = c >> 4, half = (c >> 3) & 1;
            const int per = (tot + 7) >> 3, lim = ((g + 1) * per < tot) ? (g + 1) * per : tot;
            tl = g * per + (i >> 1) * 16 + pg; u.pn = 2 * half + (i & 1);
            if (tl >= lim) return false;
        } else if (NPN == 2 && G == 256) {
            const int g = c & 7, pg = c >> 4, half = (c >> 3) & 1;
            const int per = (tot + 7) >> 3, lim = ((g + 1) * per < tot) ? (g + 1) * per : tot;
            tl = g * per + i * 16 + pg; u.pn = half;
            if (tl >= lim) return false;
        } else if (NPN == 4) {
            const int P = (c & 7) | ((c >> 4) << 3), half = (c >> 3) & 1;
            tl = (i >> 1) * (G >> 1) + P; u.pn = 2 * half + (i & 1);
            if (tl >= tot) return false;
        } else {
            const int L = i * G + c;
            if (L >= tot * NPN) return false;
            tl = L / NPN; u.pn = L % NPN;
        }
        const int e_ = (int)((volatile LAS unsigned char*)MISC)[2048 + tl];
        u.e = e_; u.pm = tl - (int)MISC[128 + e_]; return true;
    }
    __device__ __forceinline__ const char* a_base(const pg8::Unit& u) const { return GATHER ? A : A + ((size_t)MISC[32 + u.e] + (size_t)u.pm * 256) * K * 2; }
    __device__ __forceinline__ const char* b_base(const pg8::Unit& u) const { return Bt + (size_t)u.e * b_estride + (size_t)u.pn * 256 * K * 2; }
    __device__ __forceinline__ void a_voff(const pg8::Unit& u, unsigned (&v)[2][2]) const {
        const int cnt = (int)MISC[256 + u.e];
        const int t_ = tid * 64 + lane_id();
#pragma unroll
        for (int i = 0; i < 2; ++i) { int R, C; pg8::stage_rc(t_ * 16 + i * 8192, R, C);
#pragma unroll
            for (int h = 0; h < 2; ++h) { const int ri = u.pm * 256 + h * 128 + R; const int rc = ri < cnt ? ri : (cnt > 0 ? cnt - 1 : 0);
                const int tok = (u.e < 64) ? ((const GAS int*)ltok)[(size_t)u.e * TOK + rc] : rc;
                v[h][i] = (unsigned)(tok * K + C) * 2u; } }
    }
};

__device__ __forceinline__ unsigned pk4u8(const f32x4& v) {
    unsigned w = __builtin_amdgcn_cvt_pk_u8_f32(v[0] * 255.0f, 0, 0u); w = __builtin_amdgcn_cvt_pk_u8_f32(v[1] * 255.0f, 1, w); w = __builtin_amdgcn_cvt_pk_u8_f32(v[2] * 255.0f, 2, w); return __builtin_amdgcn_cvt_pk_u8_f32(v[3] * 255.0f, 3, w); }
struct EpiProj {
    static constexpr int NST = 0;
    bf16_t* P; const float* c64; const float* s64; const float* c32; const float* s32; const float* ikg; const float* ikb; float* kpart;
    __device__ __forceinline__ void operator()(const f32x4 (&acc)[2][2][4][2], const pg8::Unit& u, int wr, int wc, int fr_, int fq_) const {
        int fr = fr_, fq = fq_; asm volatile("" : "+v"(fr), "+v"(fq));
        const int pn = u.pn;
        const bool kc = (pn == 10 || pn == 11);
        f32x4 ks1[2] = {{0.f, 0.f, 0.f, 0.f}, {0.f, 0.f, 0.f, 0.f}}, ks2[2] = {{0.f, 0.f, 0.f, 0.f}, {0.f, 0.f, 0.f, 0.f}};
        int mode;
        if (pn < 4) mode = 2; else if (pn < 6) mode = 1; else if (pn < 8) mode = 0; else if (pn < 10) mode = 2; else if (pn < 12) mode = 1; else if (pn < 14) mode = 0;
        else if (pn < 26) mode = 3; else if (pn == 26) mode = 4; else mode = (wc == 0) ? 1 : (wc == 2 ? 5 : 0);
        const int row0 = u.pm * 256 + wr * 64 + fr;
        const int tcb = (pn == 26) ? (pn * 256 + 32 * (2 * wc + (fq >> 1)) + 8 * (fq & 1)) : (pn * 256 + 64 * wc + 8 * fq);
        const int bjs = (pn == 26) ? 16 : 32;
#pragma unroll
        for (int ai = 0; ai < 2; ++ai)
#pragma unroll
            for (int m = 0; m < 4; ++m) {
                const int row = row0 + ai * 128 + m * 16, t = row & (SEQ - 1);
                f32x4 x1[2] = {acc[ai][0][m][0], acc[ai][0][m][1]}, x2[2] = {acc[ai][1][m][0], acc[ai][1][m][1]};
                if (mode == 1 || mode == 2) {
#pragma unroll
                    for (int n = 0; n < 2; ++n) { const f32x4 cs = *(const GAS f32x4*)(c64 + t * 32 + 8 * fq + 4 * n), sn = *(const GAS f32x4*)(s64 + t * 32 + 8 * fq + 4 * n);
                        const f32x4 a = x1[n] * cs - x2[n] * sn, b = x2[n] * cs + x1[n] * sn; x1[n] = a; x2[n] = b;
                        if (mode == 2) { x1[n] *= QSCALE; x2[n] *= QSCALE; } }
                    if (kc) { ks1[0] += x1[0]; ks1[1] += x1[1]; ks2[0] += x2[0]; ks2[1] += x2[1]; }
                } else if (mode == 3) {
#pragma unroll
                    for (int n = 0; n < 2; ++n)
#pragma unroll
                        for (int e = 0; e < 4; ++e) { x1[n][e] = sigmoidf_(x1[n][e]); x2[n][e] = sigmoidf_(x2[n][e]); }
                } else if (mode == 4) {
#pragma unroll
                    for (int n = 0; n < 2; ++n) { const f32x4 cs = *(const GAS f32x4*)(c32 + t * 16 + 8 * (fq & 1) + 4 * n), sn = *(const GAS f32x4*)(s32 + t * 16 + 8 * (fq & 1) + 4 * n);
                        const f32x4 a = x1[n] * cs - x2[n] * sn, b = x2[n] * cs + x1[n] * sn; x1[n] = a; x2[n] = b; }
                } else if (mode == 5) {
                    float s = (x1[0][0] + x1[0][1]) + (x1[0][2] + x1[0][3]) + (x1[1][0] + x1[1][1]) + (x1[1][2] + x1[1][3]);
                    s += __shfl_xor(s, 16); s += __shfl_xor(s, 32);
                    const float mean = s * (1.f / 32.f); float q = 0.f;
#pragma unroll
                    for (int n = 0; n < 2; ++n) { x1[n] = x1[n] - mean; q += (x1[n][0] * x1[n][0] + x1[n][1] * x1[n][1]) + (x1[n][2] * x1[n][2] + x1[n][3] * x1[n][3]); }
                    q += __shfl_xor(q, 16); q += __shfl_xor(q, 32);
                    const float rstd = 1.f / sqrtf(q * (1.f / 32.f) + LN_EPS);
#pragma unroll
                    for (int n = 0; n < 2; ++n) { const f32x4 g = *(const GAS f32x4*)(ikg + 8 * fq + 4 * n), bb = *(const GAS f32x4*)(ikb + 8 * fq + 4 * n);
                        const f32x4 v = x1[n] * rstd * g + bb;
                        f32x4 o; o[0] = __shfl_xor(v[0], 32); o[1] = __shfl_xor(v[1], 32); o[2] = __shfl_xor(v[2], 32); o[3] = __shfl_xor(v[3], 32);
                        const f32x4 cs = *(const GAS f32x4*)(c32 + t * 16 + 8 * (fq & 1) + 4 * n), sn = *(const GAS f32x4*)(s32 + t * 16 + 8 * (fq & 1) + 4 * n);
                        x1[n] = (fq < 2) ? (v * cs - o * sn) : (v * cs + o * sn); }
                }
                if (mode == 3) {
                    unsigned char* gp = (unsigned char*)P + (size_t)row * (NPROJ * 2) + 2 * (C_GA + 1024 * ((pn - 14) >> 2)) + 256 * ((pn - 14) & 3) + 64 * wc + 8 * fq;
                    u32x2 g0, g1;
                    g0.x = pk4u8(x1[0]); g0.y = pk4u8(x1[1]); g1.x = pk4u8(x2[0]); g1.y = pk4u8(x2[1]);
                    *(GAS u32x2*)gp = g0; *(GAS u32x2*)(gp + 32) = g1;
                    if (m == 3) asm volatile("" ::: "memory");
                    continue;
                }
                bf16_t* rp = P + (size_t)row * NPROJ + tcb;
                u32x4 w0; w0.x = cvtpk(x1[0][0], x1[0][1]); w0.y = cvtpk(x1[0][2], x1[0][3]); w0.z = cvtpk(x1[1][0], x1[1][1]); w0.w = cvtpk(x1[1][2], x1[1][3]);
                u32x4 w1; w1.x = cvtpk(x2[0][0], x2[0][1]); w1.y = cvtpk(x2[0][2], x2[0][3]); w1.z = cvtpk(x2[1][0], x2[1][1]); w1.w = cvtpk(x2[1][2], x2[1][3]);
                *(GAS u32x4*)rp = w0; *(GAS u32x4*)(rp + bjs) = w1;
                if (m == 3) asm volatile("" ::: "memory");
            }
        if (kc) {
#pragma unroll
            for (int n = 0; n < 2; ++n)
#pragma unroll
                for (int e = 0; e < 4; ++e) {
#pragma unroll
                    for (int sh = 1; sh < 16; sh <<= 1) { ks1[n][e] += __shfl_xor(ks1[n][e], sh); ks2[n][e] += __shfl_xor(ks2[n][e], sh); } }
            if (fr == 0) { const int b = u.pm >> 3, nb = u.pm & 7, h = 4 * (pn - 10) + wc;
                float* kp = kpart + (size_t)wr * 32768 + ((size_t)(b * 8 + h) * 8 + nb) * 64 + 8 * fq;
                *(GAS f32x4*)kp = ks1[0]; *(GAS f32x4*)(kp + 4) = ks1[1]; *(GAS f32x4*)(kp + 32) = ks2[0]; *(GAS f32x4*)(kp + 36) = ks2[1]; }
        }
    }
};
#define UB0(X) ((float)((X) & 0xffu))
#define UB1(X) ((float)(((X) >> 8) & 0xffu))
#define UB2(X) ((float)(((X) >> 16) & 0xffu))
#define UB3(X) ((float)((X) >> 24))
struct EpiBranch {
    static constexpr int NST = 0;
    static constexpr bool CHAIN = true;
    const bf16_t* P; bf16_t* Mg;
    __device__ __forceinline__ void operator()(f32x4 (&acc)[2][2][4][2], const pg8::Unit& u, int wr, int wc, int fr_, int fq_) const {
        int fr = fr_, fq = fq_; asm volatile("" : "+v"(fr), "+v"(fq));
        const int br = u.e; const int gcol = (br == 0 ? C_GA : (br == 1 ? C_GB : C_GC));
        const int row0 = u.pm * 256 + wr * 64 + fr, col0 = u.pn * 256 + wc * 32 + 8 * fq;
#define GCL(x) __builtin_fmaxf((x), 0.25f)
#pragma unroll
        for (int aq = 0; aq < 4; ++aq) { const int ai = aq >> 1, mb = (aq & 1) * 2;
            u32x2 gw[4], hw[4];
#pragma unroll
            for (int g = 0; g < 4; ++g) { const int row = row0 + ai * 128 + (mb + (g >> 1)) * 16, col = col0 + (g & 1) * 128;
                const unsigned char* gp = (const unsigned char*)P + (size_t)row * (NPROJ * 2) + 2 * gcol + col;
                gw[g] = *(const GAS u32x2*)gp; hw[g] = gw[g];
                if (br < 2) hw[g] = *(const GAS u32x2*)(gp + 2 * 1024); }
            if (br < 2) {
#pragma unroll
                for (int g = 0; g < 4; ++g) { const int m = mb + (g >> 1), bj = g & 1;
                    f32x4& v0 = acc[ai][bj][m][0]; f32x4& v1 = acc[ai][bj][m][1];
                    v0[0] *= GCL(UB0(gw[g].x)) * __builtin_amdgcn_rcpf(GCL(UB0(hw[g].x))); v0[1] *= GCL(UB1(gw[g].x)) * __builtin_amdgcn_rcpf(GCL(UB1(hw[g].x)));
                    v0[2] *= GCL(UB2(gw[g].x)) * __builtin_amdgcn_rcpf(GCL(UB2(hw[g].x))); v0[3] *= GCL(UB3(gw[g].x)) * __builtin_amdgcn_rcpf(GCL(UB3(hw[g].x)));
                    v1[0] *= GCL(UB0(gw[g].y)) * __builtin_amdgcn_rcpf(GCL(UB0(hw[g].y))); v1[1] *= GCL(UB1(gw[g].y)) * __builtin_amdgcn_rcpf(GCL(UB1(hw[g].y)));
                    v1[2] *= GCL(UB2(gw[g].y)) * __builtin_amdgcn_rcpf(GCL(UB2(hw[g].y))); v1[3] *= GCL(UB3(gw[g].y)) * __builtin_amdgcn_rcpf(GCL(UB3(hw[g].y))); }
            } else {
#pragma unroll
                for (int g = 0; g < 4; ++g) { const int m = mb + (g >> 1), bj = g & 1; const int row = row0 + ai * 128 + m * 16, col = col0 + bj * 128;
                    f32x4 v0 = acc[ai][bj][m][0] * (1.0f / 255.0f), v1 = acc[ai][bj][m][1] * (1.0f / 255.0f);
                    v0[0] *= GCL(UB0(gw[g].x)); v0[1] *= GCL(UB1(gw[g].x)); v0[2] *= GCL(UB2(gw[g].x)); v0[3] *= GCL(UB3(gw[g].x));
                    v1[0] *= GCL(UB0(gw[g].y)); v1[1] *= GCL(UB1(gw[g].y)); v1[2] *= GCL(UB2(gw[g].y)); v1[3] *= GCL(UB3(gw[g].y));
                    u32x4 w; w.x = cvtpk(v0[0], v0[1]); w.y = cvtpk(v0[2], v0[3]); w.z = cvtpk(v1[0], v1[1]); w.w = cvtpk(v1[2], v1[3]);
                    *(GAS u32x4*)(Mg + (size_t)row * DM + col) = w; }
            }
            asm volatile("" ::: "memory");
        }
#undef GCL
    }
};
struct EpiY {
    static constexpr int NST = 0;
    bf16_t* O;
    __device__ __forceinline__ void operator()(const f32x4 (&acc)[2][2][4][2], const pg8::Unit& u, int wr, int wc, int fr_, int fq_) const {
        int fr = fr_, fq = fq_; asm volatile("" : "+v"(fr), "+v"(fq));
        const int row0 = u.pm * 256 + wr * 64 + fr, col0 = (u.pn & 1) * 256 + wc * 32 + 8 * fq;
        bf16_t* base = O + (size_t)(u.pn >> 1) * TOK * 512;
#pragma unroll
        for (int ai = 0; ai < 2; ++ai)
#pragma unroll
            for (int m = 0; m < 4; ++m) { bf16_t* rp = base + (size_t)(row0 + ai * 128 + m * 16) * 512 + col0;
#pragma unroll
                for (int bj = 0; bj < 2; ++bj) { const f32x4 v0 = acc[ai][bj][m][0], v1 = acc[ai][bj][m][1];
                    u32x4 w; w.x = cvtpk(v0[0], v0[1]); w.y = cvtpk(v0[2], v0[3]); w.z = cvtpk(v1[0], v1[1]); w.w = cvtpk(v1[2], v1[3]);
                    *(GAS u32x4*)(rp + bj * 128) = w; } }
    }
};
struct EpiBf16 {
    static constexpr int NST = 0;
    bf16_t* O; int ldc;
    __device__ __forceinline__ void operator()(const f32x4 (&acc)[2][2][4][2], const pg8::Unit& u, int wr, int wc, int fr_, int fq_) const {
        int fr = fr_, fq = fq_; asm volatile("" : "+v"(fr), "+v"(fq));
        const int row0 = u.pm * 256 + wr * 64 + fr, col0 = u.pn * 256 + wc * 32 + 8 * fq;
#pragma unroll
        for (int ai = 0; ai < 2; ++ai)
#pragma unroll
            for (int m = 0; m < 4; ++m) { bf16_t* rp = O + (size_t)(row0 + ai * 128 + m * 16) * ldc + col0;
#pragma unroll
                for (int bj = 0; bj < 2; ++bj) { const f32x4 v0 = acc[ai][bj][m][0], v1 = acc[ai][bj][m][1];
                    u32x4 w; w.x = cvtpk(v0[0], v0[1]); w.y = cvtpk(v0[2], v0[3]); w.z = cvtpk(v1[0], v1[1]); w.w = cvtpk(v1[2], v1[3]);
                    *(GAS u32x4*)(rp + bj * 128) = w; } }
    }
};
struct EpiGateUp {
    static constexpr int NST = 8;
    static constexpr bool PRE = true;
    bf16_t* H; const float* lw; volatile LAS unsigned* MISC; unsigned char* dump;
    __device__ __forceinline__ void pre(const pg8::Unit& u, int wr, int lane, float& p0, float& p1) const {
        const int e = u.e, cnt = (int)MISC[256 + e];
        const int ra = u.pm * 256 + wr * 64 + lane, rb = ra + 128, cl = cnt > 0 ? cnt - 1 : 0;
        const int ca = ra < cnt ? ra : cl, cb = rb < cnt ? rb : cl;
        p0 = 1.0f; p1 = 1.0f;
        if (e < 64) { p0 = ((const GAS float*)lw)[(size_t)e * TOK + ca]; p1 = ((const GAS float*)lw)[(size_t)e * TOK + cb]; }
    }
    __device__ __forceinline__ void operator()(const f32x4 (&acc)[2][2][4][2], const pg8::Unit& u, int wr, int wc, int fr_, int fq_, float p0, float p1) const {
        int fr = fr_, fq = fq_; asm volatile("" : "+v"(fr), "+v"(fq));
        const int e = u.e, cnt = (int)MISC[256 + e]; const size_t slot0 = (size_t)MISC[32 + e];
        const int r0 = u.pm * 256 + wr * 64 + fr, f0 = u.pn * 128 + wc * 32 + 8 * fq;
        float wts[8];
#pragma unroll
        for (int g = 0; g < 8; ++g) wts[g] = __shfl((g >> 2) ? p1 : p0, fr + (g & 3) * 16);
#pragma unroll
        for (int ai = 0; ai < 2; ++ai)
#pragma unroll
            for (int m = 0; m < 4; ++m) { const int ri = r0 + ai * 128 + m * 16;
                {
                    const float wt = wts[ai * 4 + m];
                    const f32x4 g0 = acc[ai][0][m][0], g1 = acc[ai][0][m][1], u0 = acc[ai][1][m][0], u1 = acc[ai][1][m][1];
                    float h[8];
#pragma unroll
                    for (int j = 0; j < 4; ++j) { h[j] = g0[j] * sigmoidf_(g0[j]) * u0[j] * wt; h[4 + j] = g1[j] * sigmoidf_(g1[j]) * u1[j] * wt; }
                    u32x4 w; w.x = cvtpk(h[0], h[1]); w.y = cvtpk(h[2], h[3]); w.z = cvtpk(h[4], h[5]); w.w = cvtpk(h[6], h[7]);
                    bf16_t* dst = (ri < cnt) ? (H + (slot0 + ri) * EDIM + f0) : (bf16_t*)(dump + (size_t)(fr * 4 + fq) * 32);
                    *(GAS u32x4*)dst = w; } }
    }
};
struct EpiDown {
    static constexpr int NST = 0;
    unsigned char* Y8; bf16_t* YS; volatile LAS unsigned* MISC; unsigned char* dump;
    __device__ __forceinline__ void operator()(const f32x4 (&acc)[2][2][4][2], const pg8::Unit& u, int wr, int wc, int fr_, int fq_) const {
        int fr = fr_, fq = fq_; asm volatile("" : "+v"(fr), "+v"(fq));
        const int e = u.e, cnt = (int)MISC[256 + e]; const size_t slot0 = (size_t)MISC[32 + e];
        const int r0 = u.pm * 256 + wr * 64 + fr, colb = u.pn * 256 + wc * 64 + 16 * fq;
        unsigned char* dmp = dump + (size_t)(fr * 4 + fq) * 32;
#pragma unroll
        for (int ai = 0; ai < 2; ++ai)
#pragma unroll
            for (int m = 0; m < 4; ++m) { const int ri = r0 + ai * 128 + m * 16; const bool ok = ri < cnt;
                const f32x4 a0 = acc[ai][0][m][0], a1 = acc[ai][0][m][1], b0 = acc[ai][1][m][0], b1 = acc[ai][1][m][1];
                if (e < 64) {
                    float v[16] = {a0[0], a0[1], a0[2], a0[3], a1[0], a1[1], a1[2], a1[3], b0[0], b0[1], b0[2], b0[3], b1[0], b1[1], b1[2], b1[3]};
#pragma unroll
                    for (int i = 0; i < 16; ++i) v[i] = __builtin_amdgcn_fmed3f(v[i] * Y8_SCALE, -440.f, 440.f);
                    u32x4 w;
                    { int p = __builtin_amdgcn_cvt_pk_fp8_f32(v[0], v[1], 0, false); p = __builtin_amdgcn_cvt_pk_fp8_f32(v[2], v[3], p, true); w.x = (unsigned)p; }
                    { int p = __builtin_amdgcn_cvt_pk_fp8_f32(v[4], v[5], 0, false); p = __builtin_amdgcn_cvt_pk_fp8_f32(v[6], v[7], p, true); w.y = (unsigned)p; }
                    { int p = __builtin_amdgcn_cvt_pk_fp8_f32(v[8], v[9], 0, false); p = __builtin_amdgcn_cvt_pk_fp8_f32(v[10], v[11], p, true); w.z = (unsigned)p; }
                    { int p = __builtin_amdgcn_cvt_pk_fp8_f32(v[12], v[13], 0, false); p = __builtin_amdgcn_cvt_pk_fp8_f32(v[14], v[15], p, true); w.w = (unsigned)p; }
                    unsigned char* dst = ok ? (Y8 + (slot0 + (size_t)ri) * DM + colb) : dmp;
                    *(GAS u32x4*)dst = w;
                } else {
                    u32x4 w0, w1;
                    w0.x = cvtpk(a0[0], a0[1]); w0.y = cvtpk(a0[2], a0[3]); w0.z = cvtpk(a1[0], a1[1]); w0.w = cvtpk(a1[2], a1[3]);
                    w1.x = cvtpk(b0[0], b0[1]); w1.y = cvtpk(b0[2], b0[3]); w1.z = cvtpk(b1[0], b1[1]); w1.w = cvtpk(b1[2], b1[3]);
                    bf16_t* dst = ok ? (YS + (size_t)ri * DM + colb) : (bf16_t*)dmp;
                    *(GAS u32x4*)dst = w0; *(GAS u32x4*)(dst + 8) = w1;
                } }
    }
};

__device__ __forceinline__ void ph_kmean(Frame& F) {
    const bf16_t* P = (const bf16_t*)(F.ws + WS_PROJ); float* km = (float*)(F.ws + WS_KMEAN);
    LAS float* red = (LAS float*)F.lds;
    for (int item = F.bid; item < 256; item += F.G) {
        const int b = item >> 5, n = (item >> 2) & 7, cq = item & 3;
        const int col = F.tid & 127, rq = F.tid >> 7;
        const GAS bf16_t* p = (const GAS bf16_t*)P + (size_t)(b * SEQ + n * 256 + rq * 64) * NPROJ + C_KC + cq * 128 + col;
        float s = 0.f;
#pragma unroll 8
        for (int r = 0; r < 64; ++r) s += bf2f(p[(size_t)r * NPROJ]);
        red[rq * 128 + col] = s;
        __syncthreads();
        if (F.tid < 128) { const float tot = ((red[col] + red[128 + col]) + red[256 + col]) + red[384 + col]; const int cc = cq * 128 + col, h = cc >> 6, d = cc & 63;
            km[((size_t)(b * 8 + h) * 8 + n) * 64 + d] = tot * (1.0f / 256.0f); }
        __syncthreads();
    }
}
__device__ __forceinline__ int crow(int r, int hi) { return (r & 3) + 8 * (r >> 2) + 4 * hi; }
__device__ __forceinline__ s16x4 vtr(const LAS unsigned char* p) { return __builtin_bit_cast(s16x4, __builtin_amdgcn_ds_read_tr16_b64_v4i16((LAS s16x4*)p)); }

constexpr float FNEG = -1e30f, FTHR = 8.0f;
struct FlashState { f32x16 o0, o1, cN, cF; float mref, lrun; bool started; int cur_nb; unsigned pat; };
#ifndef V1EARLY
#define V1EARLY 1
#endif
template <int MODE>
__device__ __forceinline__ void flash_step(FlashState& st, const bf16x8 (&qf)[4], const LAS unsigned char* kvb, int kt, int qt, int tq, int q, int hi, int krd, int ksw, int vrd,
                                           const LAS unsigned* maskw, unsigned selbits, int own) {
    const int key0 = 64 * kt;
    bool active = (key0 <= 32 * qt + 31);
    if (MODE == 2) { const int nb = kt >> 2; if (nb != own && __ballot((selbits >> nb) & 1u) == 0ull) active = false; }
    if (!active) return;
    const bool diag = (key0 + 63 > 32 * qt);
    int cls = 0;
    if (MODE == 1) { const int dmin = 32 * qt - key0 - 63, dmax = 32 * qt + 31 - key0; cls = (dmin > 512) ? 1 : ((dmin > 128 && dmax <= 512) ? 2 : 3);
        if (cls != st.cur_nb) { st.cur_nb = cls;
            const float v16 = (cls == 2) ? 1.0f : 0.f, v4 = (cls == 1) ? FNEG : 0.f, v0 = (cls == 3) ? 0.f : FNEG;
#pragma unroll
            for (int r = 0; r < 16; ++r) { const bool c16 = (st.pat >> r) & 1u, c4 = (st.pat >> (16 + r)) & 1u; st.cN[r] = (c16 ? v16 : (c4 ? v4 : v0)) - st.mref; } }
        cls = 0; }
    if (MODE == 2) { const int nb = kt >> 2;
        if (nb != st.cur_nb) { st.cur_nb = nb; const bool sel = (nb == own) || (((selbits >> nb) & 1u) != 0u);
#pragma unroll
            for (int r = 0; r < 16; ++r) st.cF[r] = sel ? st.cN[r] : FNEG; }
        cls = 1; }
    f32x16 p0, p1;
    bf16x8 kf0[4], kf1[4];
#pragma unroll
    for (int s = 0; s < ((MODE == 1 && !V1EARLY) ? 2 : 4); ++s) { kf0[s] = *(const LAS bf16x8*)(kvb + krd + (((2 * s + hi) ^ ksw) * 16)); kf1[s] = *(const LAS bf16x8*)(kvb + 4096 + krd + (((2 * s + hi) ^ ksw) * 16)); }
    __builtin_amdgcn_sched_barrier(0);
    { if (cls == 1) { p0 = __builtin_amdgcn_mfma_f32_32x32x16_bf16(kf0[0], qf[0], st.cF, 0, 0, 0); p1 = __builtin_amdgcn_mfma_f32_32x32x16_bf16(kf1[0], qf[0], st.cF, 0, 0, 0); }
      else { p0 = __builtin_amdgcn_mfma_f32_32x32x16_bf16(kf0[0], qf[0], st.cN, 0, 0, 0); p1 = __builtin_amdgcn_mfma_f32_32x32x16_bf16(kf1[0], qf[0], st.cN, 0, 0, 0); } }
    if (MODE == 1 && !V1EARLY) {
        p0 = __builtin_amdgcn_mfma_f32_32x32x16_bf16(kf0[1], qf[1], p0, 0, 0, 0); p1 = __builtin_amdgcn_mfma_f32_32x32x16_bf16(kf1[1], qf[1], p1, 0, 0, 0);
#pragma unroll
        for (int s = 2; s < 4; ++s) { kf0[s - 2] = *(const LAS bf16x8*)(kvb + krd + (((2 * s + hi) ^ ksw) * 16)); kf1[s - 2] = *(const LAS bf16x8*)(kvb + 4096 + krd + (((2 * s + hi) ^ ksw) * 16)); }
#pragma unroll
        for (int s = 2; s < 4; ++s) { p0 = __builtin_amdgcn_mfma_f32_32x32x16_bf16(kf0[s - 2], qf[s], p0, 0, 0, 0); p1 = __builtin_amdgcn_mfma_f32_32x32x16_bf16(kf1[s - 2], qf[s], p1, 0, 0, 0); }
    } else {
#pragma unroll
        for (int s = 1; s < 4; ++s) { p0 = __builtin_amdgcn_mfma_f32_32x32x16_bf16(kf0[s], qf[s], p0, 0, 0, 0); p1 = __builtin_amdgcn_mfma_f32_32x32x16_bf16(kf1[s], qf[s], p1, 0, 0, 0); }
    }
    const LAS unsigned char* vb = kvb + vrd;
    s16x4 va0[4], va1[4], vc0[4], vc1[4];
    if (MODE != 1 || V1EARLY) {
#pragma unroll
        for (int ks = 0; ks < 4; ++ks) { va0[ks] = vtr(vb + ks * 1024); va1[ks] = vtr(vb + ks * 1024 + 512); vc0[ks] = vtr(vb + 4096 + ks * 1024); vc1[ks] = vtr(vb + 4096 + ks * 1024 + 512); }
        __builtin_amdgcn_sched_barrier(0);
    }
    if (MODE == 1 && st.cur_nb == 3) {
        const int dmin = 32 * qt - key0 - 63;
        const int db = tq - key0;
        const bool s512 = dmin > 128;
        const int thr = s512 ? 512 : 128;
        const float a16 = s512 ? 1.0f : 1.5849625007f, a4 = s512 ? 0.f : 1.0f, a0 = s512 ? FNEG : 0.f;
        const float b16 = s512 ? 0.f : 1.0f, b4 = s512 ? FNEG : 0.f;
#pragma unroll
        for (int r = 0; r < 16; ++r) { const bool c16 = (st.pat >> r) & 1u, c4 = (st.pat >> (16 + r)) & 1u;
            const float lo = c16 ? a16 : (c4 ? a4 : a0), hi_ = c16 ? b16 : (c4 ? b4 : FNEG);
            const int d0 = db - crow(r, hi), d1 = d0 - 32;
            p0[r] += (d0 < 0) ? FNEG : ((d0 <= thr) ? lo : hi_); p1[r] += (d1 < 0) ? FNEG : ((d1 <= thr) ? lo : hi_); }
    } else if (MODE != 1 && diag) {
#pragma unroll
        for (int r = 0; r < 16; ++r) { const int kk = key0 + crow(r, hi); p0[r] = (kk <= tq) ? p0[r] : FNEG; p1[r] = (kk + 32 <= tq) ? p1[r] : FNEG; }
    }
    float mx;
    { float a = __builtin_fmaxf(__builtin_fmaxf(p0[0], p0[1]), p1[0]), c = __builtin_fmaxf(__builtin_fmaxf(p0[2], p0[3]), p1[1]);
      a = __builtin_fmaxf(__builtin_fmaxf(a, p1[2]), p1[3]);
#pragma unroll
      for (int r = 4; r < 16; r += 4) { a = __builtin_fmaxf(__builtin_fmaxf(a, p0[r]), p0[r + 1]); c = __builtin_fmaxf(__builtin_fmaxf(c, p0[r + 2]), p0[r + 3]);
          a = __builtin_fmaxf(__builtin_fmaxf(a, p1[r]), p1[r + 1]); c = __builtin_fmaxf(__builtin_fmaxf(c, p1[r + 2]), p1[r + 3]); }
      mx = __builtin_fmaxf(a, c);
      { auto rr = __builtin_amdgcn_permlane32_swap(__float_as_uint(mx), __float_as_uint(mx), false, false); mx = __builtin_fmaxf(__uint_as_float(rr[0]), __uint_as_float(rr[1])); } }
    const bool resc = (mx > FTHR) || (!st.started && mx > -1e29f);
    if (__any(resc)) {
        const float dl = resc ? mx : 0.f;
        st.started = st.started || resc;
        st.mref += dl;
        const float f = __builtin_amdgcn_exp2f(-dl);
        st.lrun *= f;
#pragma unroll
        for (int r = 0; r < 16; ++r) { p0[r] -= dl; p1[r] -= dl; st.o0[r] *= f; st.o1[r] *= f; if (MODE == 1) st.cN[r] -= dl; else st.cN[r] = -st.mref; }
        if (MODE == 2) st.cur_nb = -1;
    }
    float ls = 0.f;
    if (MODE == 0) {
        const unsigned w0 = maskw[q * 65 + 2 * kt], w1 = maskw[q * 65 + 2 * kt + 1];
#pragma unroll
        for (int r = 0; r < 16; ++r) { const int kk = crow(r, hi);
            const float e0 = __uint_as_float(__float_as_uint(__builtin_amdgcn_exp2f(p0[r])) & (unsigned)__builtin_amdgcn_sbfe((int)w0, kk, 1));
            const float e1 = __uint_as_float(__float_as_uint(__builtin_amdgcn_exp2f(p1[r])) & (unsigned)__builtin_amdgcn_sbfe((int)w1, kk, 1));
            p0[r] = e0; p1[r] = e1; ls += e0 + e1; }
    } else {
#pragma unroll
        for (int r = 0; r < 16; ++r) { const float e0 = __builtin_amdgcn_exp2f(p0[r]), e1 = __builtin_amdgcn_exp2f(p1[r]); p0[r] = e0; p1[r] = e1; ls += e0 + e1; }
    }
    st.lrun += ls;
    bf16x8 pb[4];
    { u32x4 w;
      w.x = cvtpk(p0[0], p0[1]); w.y = cvtpk(p0[2], p0[3]); w.z = cvtpk(p0[4], p0[5]); w.w = cvtpk(p0[6], p0[7]); pb[0] = __builtin_bit_cast(bf16x8, w);
      w.x = cvtpk(p0[8], p0[9]); w.y = cvtpk(p0[10], p0[11]); w.z = cvtpk(p0[12], p0[13]); w.w = cvtpk(p0[14], p0[15]); pb[1] = __builtin_bit_cast(bf16x8, w);
      w.x = cvtpk(p1[0], p1[1]); w.y = cvtpk(p1[2], p1[3]); w.z = cvtpk(p1[4], p1[5]); w.w = cvtpk(p1[6], p1[7]); pb[2] = __builtin_bit_cast(bf16x8, w);
      w.x = cvtpk(p1[8], p1[9]); w.y = cvtpk(p1[10], p1[11]); w.z = cvtpk(p1[12], p1[13]); w.w = cvtpk(p1[14], p1[15]); pb[3] = __builtin_bit_cast(bf16x8, w); }
    if (MODE == 1 && !V1EARLY) {
#pragma unroll
        for (int ks = 0; ks < 4; ++ks) { va0[ks] = vtr(vb + ks * 1024); va1[ks] = vtr(vb + ks * 1024 + 512); vc0[ks] = vtr(vb + 4096 + ks * 1024); vc1[ks] = vtr(vb + 4096 + ks * 1024 + 512); }
    }
#pragma unroll
    for (int ks = 0; ks < 4; ++ks) {
        const s16x4 a0 = va0[ks], a1 = va1[ks], c0 = vc0[ks], c1 = vc1[ks];
        const bf16x8 va = {a0[0], a0[1], a0[2], a0[3], a1[0], a1[1], a1[2], a1[3]}, vc = {c0[0], c0[1], c0[2], c0[3], c1[0], c1[1], c1[2], c1[3]};
        st.o0 = __builtin_amdgcn_mfma_f32_32x32x16_bf16(va, pb[ks], st.o0, 0, 0, 0);
        st.o1 = __builtin_amdgcn_mfma_f32_32x32x16_bf16(vc, pb[ks], st.o1, 0, 0, 0);
    }
}
__device__ __forceinline__ void glds16_asm(const GAS void* g, unsigned lds_base) {
    unsigned sv; asm volatile("s_mov_b32 %0, m0\n\ts_mov_b32 m0, %2\n\ts_nop 0\n\tglobal_load_lds_dwordx4 %1, off\n\ts_mov_b32 m0, %0" : "=&s"(sv) : "v"(g), "s"(lds_base) : "memory"); }
template <int MODE>
__device__ __forceinline__ void flash_block(const bf16_t* P, int b, int nkt, int qt, int qcol, int kcol, int vcol, bf16_t* Oout  ,
                                            LAS unsigned char* kv  , const LAS unsigned* maskw  , unsigned selbits  , int tid_) {
    int tid = tid_; asm volatile("" : "+v"(tid));
    const int lane = tid & 63, q = lane & 31, hi = lane >> 5;
    const int tq = 32 * qt + q;
    const GAS bf16_t* Pb = (const GAS bf16_t*)P + (size_t)b * SEQ * NPROJ;
    bf16x8 qf[4];
#pragma unroll
    for (int s = 0; s < 4; ++s) qf[s] = *(const GAS bf16x8*)(Pb + (size_t)tq * NPROJ + qcol + 16 * s + 8 * hi);
    FlashState st; st.mref = 0.f; st.lrun = 0.f; st.started = false; st.cur_nb = -1;
#pragma unroll
    for (int r = 0; r < 16; ++r) { st.o0[r] = 0.f; st.o1[r] = 0.f; st.cN[r] = 0.f; st.cF[r] = 0.f; }
    st.pat = 0u;
    if (MODE == 1) {
#pragma unroll
        for (int r = 0; r < 16; ++r) { const int dm = (tq - crow(r, hi)) & 15; st.pat |= ((dm == 0) ? (1u << r) : 0u) | (((dm & 3) == 0) ? (1u << (16 + r)) : 0u); }
    }
    const int own = qt >> 3;
    const int wv = __builtin_amdgcn_readfirstlane(tid >> 6);
    const int krow = 8 * wv + (lane >> 3), kch = (lane & 7) ^ ((krow >> 1) & 7);
    const int vrow = 16 * (wv & 3) + (lane >> 2), vch = 4 * (wv >> 2) + (lane & 3);
    const GAS bf16_t* kg = Pb + (size_t)krow * NPROJ + kcol + 8 * kch;
    const GAS bf16_t* vg = Pb + (size_t)vrow * NPROJ + vcol + 8 * vch;
    const int krd = q * 128, ksw = (q >> 1) & 7;
    const int vrd = 8192 + ((lane >> 4) & 1) * 32 + (lane & 3) * 8 + (4 * hi + ((lane & 15) >> 2)) * 64;
    const size_t tstride = (size_t)64 * NPROJ;
    LAS unsigned char* kvw = kv + 1024 * wv;
    const unsigned kvw_a = (unsigned)__builtin_amdgcn_readfirstlane((int)(unsigned)(unsigned long long)kvw);
#define FB_STAGE(t, bufoff) do { glds16_asm(kg + (size_t)(t) * tstride, kvw_a + (unsigned)(bufoff)); glds16_asm(vg + (size_t)(t) * tstride, kvw_a + (unsigned)(bufoff) + 8192u); } while (0)
    const int ntm1 = nkt - 1;
    { const int t1 = 1 < ntm1 ? 1 : ntm1; FB_STAGE(0, 0); FB_STAGE(t1, 16384); }
    asm volatile("s_waitcnt vmcnt(0)" : "+v"(qf[0]), "+v"(qf[1]), "+v"(qf[2]), "+v"(qf[3]) :: "memory");
    __syncthreads();
    for (int kt = 0; kt < nkt; kt += 2) {
        const int sb = (kt & 2) * 16384;
        { const int t2 = kt + 2 < ntm1 ? kt + 2 : ntm1, t3 = kt + 3 < ntm1 ? kt + 3 : ntm1, ob = sb ^ 32768;
          FB_STAGE(t2, ob); FB_STAGE(t3, ob + 16384); }
        flash_step<MODE>(st, qf, kv + sb, kt, qt, tq, q, hi, krd, ksw, vrd, maskw, selbits, own);
        if (kt + 1 < nkt) flash_step<MODE>(st, qf, kv + sb + 16384, kt + 1, qt, tq, q, hi, krd, ksw, vrd, maskw, selbits, own);
        asm volatile("s_waitcnt vmcnt(0)" ::: "memory");
        __syncthreads();
    }
#undef FB_STAGE
    st.lrun += __shfl_xor(st.lrun, 32);
    const float rl = 1.0f / st.lrun;
    bf16_t* orow = Oout + (size_t)(b * SEQ + tq) * 512;
#pragma unroll
    for (int g = 0; g < 4; ++g) {
        u32x2 w; w.x = cvtpk(st.o0[4 * g] * rl, st.o0[4 * g + 1] * rl); w.y = cvtpk(st.o0[4 * g + 2] * rl, st.o0[4 * g + 3] * rl);
        *(GAS u32x2*)(orow + 8 * g + 4 * hi) = w;
        u32x2 x; x.x = cvtpk(st.o1[4 * g] * rl, st.o1[4 * g + 1] * rl); x.y = cvtpk(st.o1[4 * g + 2] * rl, st.o1[4 * g + 3] * rl);
        *(GAS u32x2*)(orow + 32 + 8 * g + 4 * hi) = x;
    }
}

constexpr int A_QI_OFF = 0, A_MASK_OFF = 16896, A_RED_OFF = 25216, A_FLAG_OFF = 27264, A_V_OFF = 32768;
__device__ __forceinline__ int wave_sum_dpp(int x) {
    x += __builtin_amdgcn_update_dpp(0, x, 0xB1, 0xF, 0xF, true);
    x += __builtin_amdgcn_update_dpp(0, x, 0x4E, 0xF, 0xF, true);
    x += __builtin_amdgcn_update_dpp(0, x, 0x141, 0xF, 0xF, true);
    x += __builtin_amdgcn_update_dpp(0, x, 0x140, 0xF, 0xF, true);
    return (__builtin_amdgcn_readlane(x, 0) + __builtin_amdgcn_readlane(x, 16)) + (__builtin_amdgcn_readlane(x, 32) + __builtin_amdgcn_readlane(x, 48));
}
__device__ __forceinline__ void dsa_unit(Frame& F, int b, int qt) {
    const bf16_t* P = (const bf16_t*)(F.ws + WS_PROJ);
    const GAS bf16_t* Pb = (const GAS bf16_t*)P + (size_t)b * SEQ * NPROJ;
    int w_ = F.wave; asm volatile("" : "+s"(w_)); int tid_ = w_ * 64 + lane_id();
    const int tid = tid_, lane = tid_ & 63, w = w_, q = lane & 31, hi = lane >> 5, tq = 32 * qt + q;
    LAS unsigned char* qis = F.lds + A_QI_OFF;
    LAS unsigned* maskw = (LAS unsigned*)(F.lds + A_MASK_OFF);
    LAS int* red = (LAS int*)(F.lds + A_RED_OFF);
    volatile LAS unsigned* flag = (volatile LAS unsigned*)(F.lds + A_FLAG_OFF);
    for (int id = tid; id < 1024; id += NTHREADS) { const int r = id >> 5, c = id & 31; *(LAS u32x4*)(qis + r * 528 + c * 16) = *(const GAS u32x4*)(Pb + (size_t)(32 * qt + r) * NPROJ + C_QI + 8 * c); }
    if (tid == 0) flag[0] = 0u;
    float wh[8];
    { const u32x4 ww = *(const GAS u32x4*)(Pb + (size_t)tq * NPROJ + C_WI);
      wh[0] = bflo(ww.x); wh[1] = bfhi(ww.x); wh[2] = bflo(ww.y); wh[3] = bfhi(ww.y); wh[4] = bflo(ww.z); wh[5] = bfhi(ww.z); wh[6] = bflo(ww.w); wh[7] = bfhi(ww.w);
#pragma unroll
      for (int h = 0; h < 8; ++h) wh[h] *= 0.0625f; }
    __syncthreads();
    const int nkt32 = qt + 1;
    const int nslots = (nkt32 - w + 7) >> 3;
    unsigned code[8][16];
#pragma unroll 1
    for (int rep_s = 0; rep_s < (PROBE_DSA == 1 ? 2 : 1); ++rep_s) {
    bf16x8 kfr[8][2];
#pragma unroll
    for (int j = 0; j < 8; ++j) { const int key0 = 32 * (w + 8 * j);
        kfr[j][0] = *(const GAS bf16x8*)(Pb + (size_t)(key0 + q) * NPROJ + C_KI + 8 * hi); kfr[j][1] = *(const GAS bf16x8*)(Pb + (size_t)(key0 + q) * NPROJ + C_KI + 16 + 8 * hi); }
#pragma unroll
    for (int j = 0; j < 8; ++j) {
#pragma unroll
        for (int r = 0; r < 16; ++r) code[j][r] = 0u;
        if (j < nslots) {
            const int key0 = 32 * (w + 8 * j);
            const bf16x8 k0 = kfr[j][0], k1 = kfr[j][1];
            float sc[16];
#pragma unroll
            for (int r = 0; r < 16; ++r) sc[r] = 0.f;
#pragma unroll
            for (int h = 0; h < 8; ++h) {
                const bf16x8 q0 = *(const LAS bf16x8*)(qis + q * 528 + h * 64 + hi * 16), q1 = *(const LAS bf16x8*)(qis + q * 528 + h * 64 + 32 + hi * 16);
                f32x16 a;
#pragma unroll
                for (int r = 0; r < 16; ++r) a[r] = 0.f;
                a = __builtin_amdgcn_mfma_f32_32x32x16_bf16(k0, q0, a, 0, 0, 0);
                a = __builtin_amdgcn_mfma_f32_32x32x16_bf16(k1, q1, a, 0, 0, 0);
#pragma unroll
                for (int r = 0; r < 16; ++r) { const float t = __builtin_amdgcn_fmed3f(a[r], 0.f, INFINITY); asm("v_fmac_f32_e32 %0, %1, %2" : "+v"(sc[r]) : "v"(wh[h]), "v"(t)); }
                __builtin_amdgcn_sched_barrier(0);
            }
#pragma unroll
            for (int r = 0; r < 16; ++r) { const float v = sc[r] + 0.0f; const unsigned ub = __float_as_uint(v); const unsigned mc = (ub & 0x80000000u) ? ~ub : (ub | 0x80000000u);
                code[j][r] = (key0 + crow(r, hi) <= tq) ? mc : 0u; }
        }
    }
    }
#pragma unroll 1
    for (int rep_t = 0; rep_t < (PROBE_DSA == 2 ? 2 : 1); ++rep_t) {
    LAS unsigned* T = (LAS unsigned*)F.lds;
    unsigned c2[4][32];
#pragma unroll
    for (int j = 0; j < 8; ++j) {
        if (8 * j >= nkt32) {
#pragma unroll
            for (int i = 0; i < 4; ++i)
#pragma unroll
                for (int cc = 0; cc < 4; ++cc) c2[i][4 * j + cc] = 0u;
            continue;
        }
        __syncthreads();
#pragma unroll
        for (int r = 0; r < 16; ++r) T[q * 257 + 32 * w + crow(r, hi)] = code[j][r];
        __syncthreads();
#pragma unroll
        for (int i = 0; i < 4; ++i)
#pragma unroll
            for (int cc = 0; cc < 4; ++cc) c2[i][4 * j + cc] = T[(4 * w + i) * 257 + 64 * cc + lane];
    }
    __syncthreads();
    const int lane2 = lane_id();
    const int ncc = (32 * qt + 31) / 64 + 1;
    unsigned pfx[4] = {0u, 0u, 0u, 0u}; int cge[4] = {0x7fffffff, 0x7fffffff, 0x7fffffff, 0x7fffffff};
    for (int bit = 31; bit >= 0; --bit) {
        int cnt[4] = {0, 0, 0, 0};
        const unsigned cd0 = __builtin_amdgcn_readfirstlane(pfx[0] | (1u << bit)), cd1 = __builtin_amdgcn_readfirstlane(pfx[1] | (1u << bit)), cd2 = __builtin_amdgcn_readfirstlane(pfx[2] | (1u << bit)), cd3 = __builtin_amdgcn_readfirstlane(pfx[3] | (1u << bit));
        int nc = ncc; asm volatile("" : "+s"(nc));
        int n0 = 0, n1 = 0, n2 = 0, n3 = 0;
#define SEL_ONE(c) do { unsigned long long m0, m1, m2, m3; \
            asm volatile("v_cmp_le_u32_e64 %[m0], %[c0], %[x0]\n\tv_cmp_le_u32_e64 %[m1], %[c1], %[x1]\n\tv_cmp_le_u32_e64 %[m2], %[c2], %[x2]\n\tv_cmp_le_u32_e64 %[m3], %[c3], %[x3]\n\t" \
                         "v_addc_co_u32_e64 %[n0], %[m0], 0, %[n0], %[m0]\n\tv_addc_co_u32_e64 %[n1], %[m1], 0, %[n1], %[m1]\n\tv_addc_co_u32_e64 %[n2], %[m2], 0, %[n2], %[m2]\n\tv_addc_co_u32_e64 %[n3], %[m3], 0, %[n3], %[m3]" \
                         : [n0] "+v"(n0), [n1] "+v"(n1), [n2] "+v"(n2), [n3] "+v"(n3), [m0] "=&s"(m0), [m1] "=&s"(m1), [m2] "=&s"(m2), [m3] "=&s"(m3) \
                         : [c0] "s"(cd0), [c1] "s"(cd1), [c2] "s"(cd2), [c3] "s"(cd3), [x0] "v"(c2[0][c]), [x1] "v"(c2[1][c]), [x2] "v"(c2[2][c]), [x3] "v"(c2[3][c])); } while (0)
#pragma unroll
        for (int c = 0; c < 32; c += 8) if (c < nc) { SEL_ONE(c); SEL_ONE(c + 1); SEL_ONE(c + 2); SEL_ONE(c + 3); SEL_ONE(c + 4); SEL_ONE(c + 5); SEL_ONE(c + 6); SEL_ONE(c + 7); }
#undef SEL_ONE
        { int t01 = n0 | (n1 << 16), t23 = n2 | (n3 << 16);
          t01 = wave_sum_dpp(t01); t23 = wave_sum_dpp(t23);
          n0 = t01 & 0xffff; n1 = (int)((unsigned)t01 >> 16); n2 = t23 & 0xffff; n3 = (int)((unsigned)t23 >> 16); }
        cnt[0] = n0; cnt[1] = n1; cnt[2] = n2; cnt[3] = n3;
        if (cnt[0] >= 256) { pfx[0] = cd0; cge[0] = cnt[0]; } if (cnt[1] >= 256) { pfx[1] = cd1; cge[1] = cnt[1]; } if (cnt[2] >= 256) { pfx[2] = cd2; cge[2] = cnt[2]; } if (cnt[3] >= 256) { pfx[3] = cd3; cge[3] = cnt[3]; }
        if (cge[0] == 256 && cge[1] == 256 && cge[2] == 256 && cge[3] == 256) break;
    }
#pragma unroll
    for (int i = 0; i < 4; ++i) {
        const int ql = 4 * w + i;
        const unsigned pf = pfx[i];
        if (cge[i] == 256) {
#pragma unroll
            for (int c = 0; c < 32; ++c) { const unsigned long long sel = __ballot(c2[i][c] >= pf);
                if (lane2 < 2) maskw[ql * 65 + 2 * c + lane2] = lane2 ? (unsigned)(sel >> 32) : (unsigned)sel; }
            continue;
        }
        int cgt = 0; int nc = ncc; asm volatile("" : "+s"(nc));
#pragma unroll
        for (int c = 0; c < 32; ++c) if (c < nc) cgt += __builtin_popcountll(__ballot(c2[i][c] > pf));
        int need = 256 - cgt;
#pragma unroll
        for (int c = 0; c < 32; ++c) {
            unsigned long long sel = 0ull;
            if (c < nc) {
                sel = __ballot(c2[i][c] > pf);
                unsigned long long eq = __ballot(c2[i][c] == pf);
                int ne = __builtin_popcountll(eq);
                if (ne > need) { int drop = ne - need; while (drop > 0) { eq &= ~(1ull << (63 - __builtin_clzll(eq))); --drop; } ne = need; }
                need -= ne; sel |= eq;
            }
            if (lane2 < 2) maskw[ql * 65 + 2 * c + lane2] = lane2 ? (unsigned)(sel >> 32) : (unsigned)sel;
        }
    }
    __syncthreads();
    }
#pragma unroll 1
    for (int rep_f = 0; rep_f < (PROBE_DSA == 3 ? 2 : 1); ++rep_f)
    flash_block<0>(P, b, (32 * qt + 31) / 64 + 1, qt, C_QA + 64 * w, C_KA, C_VA, (bf16_t*)(F.ws + WS_OABC) + 64 * w, F.lds + A_V_OFF, maskw, 0u, w * 64 + lane_id());
}
__device__ __forceinline__ unsigned moba_select(const bf16_t* P, const LAS float* kml  , int b, int h, int qt, int lane_) {
    int lane = lane_; asm volatile("" : "+v"(lane));
    const int q = lane & 31, hi = lane >> 5, tq = 32 * qt + q, own = qt >> 3;
    if (own == 0) return 0u;
    const GAS bf16_t* qp = (const GAS bf16_t*)P + (size_t)(b * SEQ + tq) * NPROJ + C_QC + 64 * h;
    float qv[32];
#pragma unroll
    for (int s = 0; s < 4; ++s) { const u32x4 w = *(const GAS u32x4*)(qp + 16 * s + 8 * hi);
        qv[8 * s] = bflo(w.x); qv[8 * s + 1] = bfhi(w.x); qv[8 * s + 2] = bflo(w.y); qv[8 * s + 3] = bfhi(w.y); qv[8 * s + 4] = bflo(w.z); qv[8 * s + 5] = bfhi(w.z); qv[8 * s + 6] = bflo(w.w); qv[8 * s + 7] = bfhi(w.w); }
    float g[7];
#pragma unroll
    for (int n = 0; n < 7; ++n) { g[n] = -INFINITY;
        { const LAS float* kp = kml + n * 64; float s = 0.f;
#pragma unroll
            for (int sgm = 0; sgm < 4; ++sgm) { const f32x4 k0 = *(const LAS f32x4*)(kp + 16 * sgm + 8 * hi), k1 = *(const LAS f32x4*)(kp + 16 * sgm + 8 * hi + 4);
                s += qv[8 * sgm] * k0[0] + qv[8 * sgm + 1] * k0[1] + qv[8 * sgm + 2] * k0[2] + qv[8 * sgm + 3] * k0[3] + qv[8 * sgm + 4] * k1[0] + qv[8 * sgm + 5] * k1[1] + qv[8 * sgm + 6] * k1[2] + qv[8 * sgm + 7] * k1[3]; }
            s += __shfl_xor(s, 32); g[n] = s; } }
    unsigned sel = 0u;
#pragma unroll
    for (int n = 0; n < 7; ++n) { int rk = 0;
#pragma unroll
        for (int n2 = 0; n2 < 7; ++n2) rk += (n2 < own && n2 != n && (g[n2] > g[n] || (g[n2] == g[n] && n2 < n))) ? 1 : 0;
        if (n < own && rk < 3) sel |= 1u << n; }
    return sel;
}
__device__ __forceinline__ void ph_attn_a(Frame& F) {
    for (int p0_ = F.bid; p0_ < 256; p0_ += F.G) { const int p = GRP_MAJOR(p0_, F.G); const int b = p >> 5, j = p & 31;
#pragma unroll 1
        for (int u = 0; u < 2; ++u) dsa_unit(F, b, u ? 63 - j : j); }
}
__device__ __forceinline__ void ph_attn_bc(Frame& F) {
    const bf16_t* P = (const bf16_t*)(F.ws + WS_PROJ); const float* km = (const float*)(F.ws + WS_KMEAN);
    bf16_t* OB = (bf16_t*)(F.ws + WS_OABC) + (size_t)TOK * 512; bf16_t* OC = OB + (size_t)TOK * 512;
    const int w = F.wave;
    LAS unsigned char* kv = F.lds + A_V_OFF;
    for (int p0_ = F.bid; p0_ < 256; p0_ += F.G) { const int p = GRP_MAJOR(p0_, F.G); const int bh = p >> 2, b = bh >> 3, h = bh & 7, j = p & 3;
        LAS float* kml = (LAS float*)F.lds;
        { int t_ = w * 64 + lane_id(); if (t_ < 448) { const GAS float* kp = (const GAS float*)km + ((size_t)(b * 8 + h) * 8) * 64 + t_; kml[t_] = kp[0] + kp[32768]; } }
        __syncthreads();
#pragma unroll 1
        for (int u = 0; u < 2; ++u) { const int qb = u ? 7 - j : j, qt = 8 * qb + w;
            flash_block<1>(P, b, 4 * (qb + 1), qt, C_QB + 64 * h, C_KB + 64 * h, C_VB + 64 * h, OB + 64 * h, kv, nullptr, 0u, F.tid);
            const unsigned sel = moba_select(P, kml, b, h, qt, F.lane);
            flash_block<2>(P, b, 4 * (qb + 1), qt, C_QC + 64 * h, C_KC + 64 * h, C_VC + 64 * h, OC + 64 * h, kv, nullptr, sel, F.tid);
        } }
}

constexpr int NPL = 11, NPHASES = 1 + NL * NPL;
__global__ void __launch_bounds__(NTHREADS, 2) fwd(Args args) {
    extern __shared__ __attribute__((aligned(16))) unsigned char lds_raw[];
    Frame F;
    F.lds = (LAS unsigned char*)lds_raw; F.MISC = (volatile LAS unsigned*)(F.lds + LDS_MISC);
    F.tid = threadIdx.x; F.lane = F.tid & 63; F.wave = __builtin_amdgcn_readfirstlane(F.tid >> 6); F.G = gridDim.x; F.bid = blockIdx.x;
    const int wave0 = F.wave;
    F.out = args.out; F.ws = args.ws;
    for (int u = F.tid; u < 512; u += NTHREADS) F.MISC[u] = 0u;
    __syncthreads();
    XcdBarrier bar; bar.bar = (gu32*)(F.ws + WS_CTL); bar.x = 0; bar.st = nullptr;
    if (!MK_PER_PHASE) bar = xcd_barrier_post((gu32*)(F.ws + WS_CTL), F.MISC, F.tid == 0);
    if (!MK_PER_PHASE && F.tid == 0) __hip_atomic_store((gu32*)(F.ws + WS_CTL) + GB_XCC(F.bid), xb_xcc_id() + 1u, __ATOMIC_RELAXED, __HIP_MEMORY_SCOPE_AGENT);
    int loc_ok = 0; unsigned lgen = 0u;
    const int lo = args.ph_lo, hi = args.ph_hi;
#define IN(k) (lo <= (k) && (k) < hi)
#define RL() do { int l_ = lane_id(), w_ = wave0; asm volatile("" : "+v"(l_), "+s"(w_)); F.lane = l_; F.wave = w_; F.tid = w_ * 64 + l_; \
        unsigned char* ws_ = args.ws; float* out_ = args.out; asm volatile("" : "+s"(ws_), "+s"(out_)); F.ws = ws_; F.out = out_; } while (0)
#define SEAM(k) do { if (IN(k) && IN((k) + 1)) xcd_barrier(bar, wave0); } while (0)
#define SEAML(k) do { if (IN(k) && IN((k) + 1)) { if (loc_ok) { ++lgen; grp_barrier((gu32*)(args.ws + WS_CTL), (int)(blockIdx.x & 7), 32u * lgen, wave0, lane_id()); } else xcd_barrier(bar, wave0); } } while (0)
    if (HAS(11) && IN(0)) { RL(); ph_ada_rope(F, args); __syncthreads(); ph_convert(F, args, 0, 0, CT_DENSE); }
    SEAM(0);
    if (!MK_PER_PHASE && XCD_LOCAL && IN(0) && IN(1)) {
        if (wave0 == 0) { const int l_ = lane_id(); bool ok = (gridDim.x == 256u); gu32* ctl = (gu32*)(args.ws + WS_CTL);
#pragma unroll
            for (int j = 0; j < 4; ++j) { const int c = l_ + 64 * j; const unsigned v = xb_ld(ctl + GB_XCC(c)), r = xb_ld(ctl + GB_XCC(c & 7)); ok = ok && (v != 0u) && (v == r); }
            const bool all = (__ballot(!ok) == 0ull);
            if (l_ == 0) F.MISC[4] = all ? 1u : 0u; }
        __syncthreads();
        loc_ok = __builtin_amdgcn_readfirstlane((int)F.MISC[4]);
    }
    for (int l = 0; l < NL; ++l) {
        const int pb = 1 + l * NPL;
        const float* xin = (l == 0) ? INP(I_X) : (const float*)F.out;
        if (HAS(0) && IN(pb + 0)) for (int rep_ = 0; rep_ < NREP(0); ++rep_) { RL(); if (rep_ > 0) xcd_barrier(bar, wave0); if (l == 0) ph_modulate(F, INP(I_X), 0); else ph_convert(F, args, l, 0, CT_DENSE); }
        SEAM(pb + 0);
#if EN_MIX
        if (HAS(1) && IN(pb + 1)) for (int rep_ = 0; rep_ < NREP(1); ++rep_) { RL(); if (rep_ > 0) xcd_barrier(bar, wave0);
            ProbDense S{(const char*)(F.ws + WS_U), (const char*)(F.ws + WS_WIN), DM, TOK / 256, NPROJ / 256, F.G, F.bid};
            EpiProj E{(bf16_t*)(F.ws + WS_PROJ), (const float*)(F.ws + WS_COS64), (const float*)(F.ws + WS_SIN64), (const float*)(F.ws + WS_COS32), (const float*)(F.ws + WS_SIN32), INP(I_IKG) + l * 32, INP(I_IKB) + l * 32, (float*)(F.ws + WS_KMEAN)};
            pg8::gemm_phase(F.lds, S, E, F.tid);
        }
        SEAML(pb + 1);
#define CONV_MOE(k) do { if (IN(pb + 2) && (int)((blockIdx.x >> 3) % 3u) == (k)) { RL(); __syncthreads(); ph_convert(F, args, l, CT_DENSE, CT_ALL); __syncthreads(); } } while (0)
        CONV_MOE(0);
        if (HAS(2) && IN(pb + 2)) for (int rep_ = 0; rep_ < NREP(2); ++rep_) { RL(); if (rep_ > 0) xcd_barrier(bar, wave0); ph_attn_a(F); }
        CONV_MOE(1);
        if (HAS(3) && IN(pb + 3)) for (int rep_ = 0; rep_ < NREP(3); ++rep_) { RL(); if (rep_ > 0) xcd_barrier(bar, wave0); ph_attn_bc(F); }
        CONV_MOE(2);
#undef CONV_MOE
        SEAML(pb + 3);
        if (HAS(4) && IN(pb + 4)) for (int rep_ = 0; rep_ < NREP(4); ++rep_) { RL(); if (rep_ > 0) xcd_barrier(bar, wave0);
            ProbBranch S{(const char*)(F.ws + WS_OABC), (const char*)(F.ws + WS_WBR), 512, F.G, F.bid};
            EpiBranch E{(const bf16_t*)(F.ws + WS_PROJ), (bf16_t*)(F.ws + WS_MERGED)};
            pg8::gemm_phase(F.lds, S, E, F.tid);
        }
        SEAML(pb + 4);
        if (HAS(5) && IN(pb + 5)) for (int rep_ = 0; rep_ < NREP(5); ++rep_) { RL(); if (rep_ > 0) xcd_barrier(bar, wave0);
            ProbDense S{(const char*)(F.ws + WS_MERGED), (const char*)(F.ws + WS_WOUT), DM, TOK / 256, DM / 256, F.G, F.bid};
            EpiY E{(bf16_t*)(F.ws + WS_OABC)};
            pg8::gemm_phase(F.lds, S, E, F.tid);
        }
        SEAML(pb + 5);
#endif
        if (HAS(6) && IN(pb + 6)) for (int rep_ = 0; rep_ < NREP(6); ++rep_) { RL(); if (rep_ > 0) xcd_barrier(bar, wave0); }
        if (HAS(7) && IN(pb + 7)) for (int rep_ = 0; rep_ < NREP(7); ++rep_) { RL(); if (rep_ > 0) xcd_barrier(bar, wave0); if (l == 0) ph_router<true>(F, args, xin, l); else ph_router<false>(F, args, xin, l); }
        SEAM(pb + 7);
        if (HAS(8) && IN(pb + 8)) for (int rep_ = 0; rep_ < NREP(8); ++rep_) { RL(); if (rep_ > 0) xcd_barrier(bar, wave0);
            load_expert_tables(F, l);
            ProbGrouped<2, true> S{(const char*)(F.ws + WS_U), (const char*)(F.ws + WS_WGU), DM, F.G, F.bid, F.MISC, (const int*)(F.ws + WS_LTOK), (size_t)512 * DM * 2, F.wave};
            EpiGateUp E{(bf16_t*)(F.ws + WS_H), (const float*)(F.ws + WS_LW), F.MISC, F.ws + WS_KMEAN + 131072 + 4096};
            pg8::gemm_phase(F.lds, S, E, F.tid);
        }
        SEAML(pb + 8);
        if (HAS(9) && IN(pb + 9)) for (int rep_ = 0; rep_ < NREP(9); ++rep_) { RL(); if (rep_ > 0) xcd_barrier(bar, wave0);
            if (!(HAS(8) && IN(pb + 8))) load_expert_tables(F, l);
            ProbGrouped<4, false> S{(const char*)(F.ws + WS_H), (const char*)(F.ws + WS_WD), EDIM, F.G, F.bid, F.MISC, nullptr, (size_t)DM * EDIM * 2, F.wave};
            EpiDown E{F.ws + WS_Y, (bf16_t*)(F.ws + WS_SHO), F.MISC, F.ws + WS_KMEAN + 131072};
            pg8::gemm_phase(F.lds, S, E, F.tid);
        }
        SEAM(pb + 9);
        if (HAS(10) && IN(pb + 10)) for (int rep_ = 0; rep_ < NREP(10); ++rep_) { RL(); if (rep_ > 0) xcd_barrier(bar, wave0); ph_combine(F, args, l, HAS(8) && IN(pb + 8)); }
    }
#undef IN
#undef SEAM
}

extern "C" void kernel_launch(void* const* d_in, const int* in_sizes, int n_in, void* d_out, int out_size, void* d_ws, size_t ws_size, hipStream_t stream) {
    static int grid = 0;
    if (grid == 0) {
        if (n_in != 23 || out_size != TOK * DM || ws_size < WS_END) { fprintf(stderr, "kernel_launch: unexpected shapes (n_in %d, out %d, ws %zu < %zu)\n", n_in, out_size, ws_size, (size_t)WS_END); grid = -1; return; }
        int dev = 0, cus = 0, per_cu = 0;
        if (hipGetDevice(&dev) != hipSuccess || hipDeviceGetAttribute(&cus, hipDeviceAttributeMultiprocessorCount, dev) != hipSuccess) { grid = -1; return; }
        if (hipFuncSetAttribute((const void*)fwd, hipFuncAttributeMaxDynamicSharedMemorySize, LDS_BYTES) != hipSuccess) { fprintf(stderr, "kernel_launch: hipFuncSetAttribute failed\n"); grid = -1; return; }
        if (hipOccupancyMaxActiveBlocksPerMultiprocessor(&per_cu, (const void*)fwd, NTHREADS, LDS_BYTES) != hipSuccess || per_cu < 1) { fprintf(stderr, "kernel_launch: occupancy query says %d\n", per_cu); }
        (void)hipGetLastError();
        grid = cus;
    }
    if (grid < 0) return;
    (void)hipMemsetAsync((char*)d_ws + WS_CTL, 0, CTL_ZERO_BYTES, stream);
    Args a{};
    for (int i = 0; i < 23; ++i) a.in[i] = (const float*)d_in[i];
    a.out = (float*)d_out; a.ws = (unsigned char*)d_ws;
#if MK_PER_PHASE
    for (int p = 0; p < NPHASES; ++p) { a.ph_lo = p; a.ph_hi = p + 1; hipLaunchKernelGGL(fwd, dim3(grid), dim3(NTHREADS), LDS_BYTES, stream, a); }
#else
    a.ph_lo = 0; a.ph_hi = NPHASES;
    hipLaunchKernelGGL(fwd, dim3(grid), dim3(NTHREADS), LDS_BYTES, stream, a);
#endif
}
```
